# Optimizing an MI355X kernel written in HIP

```python
import math
import jax
import jax.numpy as jnp
from jax import lax
import numpy as np

D_MODEL = 1024
BATCH = 4
SEQ = 4096
DEPTH = 4
DEC_BATCH = 128
DEC_SEQ = 1
PAST_LEN = 8192
PAGE_SIZE = 128

ATT_HEADS = 8
ATT_KV_HEADS = 2
HEAD_DIM = 64
WINDOW = 128
ATT_BLOCK = 128
M_INNER = D_MODEL // 2
M_HEADDIM = 64
M_HEADS = M_INNER // M_HEADDIM
M_GROUPS = 2
M_STATE = 64
CONV_W = 4
CONV_DIM = M_INNER + 2 * M_GROUPS * M_STATE
M_CHUNK = 128
HG_WIDTH = D_MODEL // 2
HG_HEADS = 4
HG_DK = HG_WIDTH // HG_HEADS
HG_DV = HG_WIDTH // HG_HEADS
HG_CHUNK = 64
D_FF = 2816
N_BRANCH = 3
ALPHA = (2.0 * DEPTH) ** 0.25
BETA = (8.0 * DEPTH) ** -0.25
LN_EPS = 1e-5
RMS_EPS = 1e-6
COL_SPLITS = (ATT_HEADS * HEAD_DIM, ATT_KV_HEADS * HEAD_DIM, ATT_KV_HEADS * HEAD_DIM,
              M_INNER, CONV_DIM, M_HEADS,
              HG_WIDTH, HG_WIDTH, HG_WIDTH, HG_WIDTH,
              N_BRANCH * D_MODEL)
N_IN = sum(COL_SPLITS)

kernel_name = 'hybrid_swa_ssd_hgrn2_deepnorm_step'


def _layernorm(x, g, b):
    xf = x.astype(jnp.float32)
    mu = jnp.mean(xf, axis=-1, keepdims=True)
    var = jnp.mean(jnp.square(xf - mu), axis=-1, keepdims=True)
    return ((xf - mu) * lax.rsqrt(var + LN_EPS) * g.astype(jnp.float32) + b.astype(jnp.float32)).astype(x.dtype)


def _rmsnorm(x, w):
    xf = x.astype(jnp.float32)
    return (xf * lax.rsqrt(jnp.mean(xf * xf, axis=-1, keepdims=True) + RMS_EPS) * w.astype(jnp.float32)).astype(x.dtype)


def _swiglu(x, wg, wu, wd):
    return (jax.nn.silu(x @ wg) * (x @ wu)) @ wd


def _blk(T, C):
    return C if T % C == 0 else T


def _split_cols(h):
    out, start = [], 0
    for size in COL_SPLITS:
        out.append(h[..., start:start + size])
        start += size
    return out


def _swa_attention(q, k, v, k_prev, v_prev, n_prev_valid, sinks):
    b, T = q.shape[0], q.shape[1]
    blk = _blk(T, ATT_BLOCK)
    nb = T // blk
    grp = ATT_HEADS // ATT_KV_HEADS
    kc = jnp.concatenate([k_prev.astype(k.dtype), k], axis=1)
    vc = jnp.concatenate([v_prev.astype(v.dtype), v], axis=1)
    idx = jnp.arange(nb)[:, None] * blk + jnp.arange(blk + WINDOW)[None, :]
    kb = kc[:, idx]
    vb = vc[:, idx]
    qb = q.reshape(b, nb, blk, ATT_KV_HEADS, grp, HEAD_DIM)
    s = jnp.einsum('bnqkgd,bnskd->bnkgqs', qb, kb).astype(jnp.float32) * (HEAD_DIM ** -0.5)
    dist = WINDOW + jnp.arange(blk)[:, None] - jnp.arange(blk + WINDOW)[None, :]
    valid = (dist >= 0) & (dist <= WINDOW) & (idx[:, None, :] >= WINDOW - n_prev_valid)
    slopes = (2.0 ** (-8.0 * jnp.arange(1, ATT_HEADS + 1, dtype=jnp.float32) / ATT_HEADS)).reshape(ATT_KV_HEADS, grp, 1, 1)
    s = jnp.where(valid[None, :, None, None], s - slopes * dist.astype(jnp.float32), -jnp.inf)
    sink = sinks.astype(jnp.float32).reshape(ATT_KV_HEADS, grp, 1, 1)
    m = jnp.maximum(jnp.max(s, axis=-1, keepdims=True), sink)
    p = jnp.exp(s - m)
    p = p / (jnp.sum(p, axis=-1, keepdims=True) + jnp.exp(sink - m))
    o = jnp.einsum('bnkgqs,bnskd->bnqkgd', p.astype(v.dtype), vb)
    return o.reshape(b, T, ATT_HEADS * HEAD_DIM), kc[:, -WINDOW:], vc[:, -WINDOW:]


def _ssd(xh, dt, A, Bm, Cm, h0):
    b, T = xh.shape[0], xh.shape[1]
    L = _blk(T, M_CHUNK)
    nc = T // L
    hpg = M_HEADS // M_GROUPS
    x = xh.astype(jnp.float32).reshape(b, nc, L, M_GROUPS, hpg, M_HEADDIM)
    dtc = dt.reshape(b, nc, L, M_GROUPS, hpg)
    Bc = Bm.astype(jnp.float32).reshape(b, nc, L, M_GROUPS, M_STATE)
    Cc = Cm.astype(jnp.float32).reshape(b, nc, L, M_GROUPS, M_STATE)
    a = jnp.cumsum(dtc * A.reshape(M_GROUPS, hpg), axis=2)
    causal = jnp.tril(jnp.ones((L, L), bool))[:, :, None, None]
    decay = jnp.exp(jnp.where(causal, a[:, :, :, None] - a[:, :, None], -jnp.inf))
    w = jnp.einsum('bctgn,bcsgn->bctsg', Cc, Bc)[..., None] * decay * dtc[:, :, None]
    y = jnp.einsum('bctsgh,bcsghp->bctghp', w, x)
    cs = jnp.einsum('bcsgh,bcsgn,bcsghp->bcghpn', jnp.exp(a[:, :, -1:] - a) * dtc, Bc, x)

    def step(hc, inp):
        dec, s_c = inp
        return dec[..., None, None] * hc + s_c, hc

    hT, hs = lax.scan(step, h0.astype(jnp.float32).reshape(b, M_GROUPS, hpg, M_HEADDIM, M_STATE),
                      (jnp.moveaxis(jnp.exp(a[:, :, -1]), 1, 0), jnp.moveaxis(cs, 1, 0)))
    y = y + jnp.einsum('bctgn,cbghpn->bctghp', Cc, hs) * jnp.exp(a)[..., None]
    return y.reshape(b, T, M_HEADS, M_HEADDIM), hT.reshape(b, M_HEADS, M_HEADDIM, M_STATE)


def _mamba2(z, xbc, dt_raw, conv_prev, h0, conv_w, conv_b, dt_bias, a_log, d_skip, norm_w):
    b, T = xbc.shape[0], xbc.shape[1]
    xcat = jnp.concatenate([conv_prev.astype(xbc.dtype), xbc], axis=1)
    conv = lax.conv_general_dilated(xcat, conv_w.astype(xbc.dtype)[:, None, :], window_strides=(1,),
                                    padding='VALID', dimension_numbers=('NWC', 'WIO', 'NWC'),
                                    feature_group_count=CONV_DIM)
    act = jax.nn.silu(conv + conv_b)
    xs = act[..., :M_INNER].reshape(b, T, M_HEADS, M_HEADDIM)
    Bm = act[..., M_INNER:M_INNER + M_GROUPS * M_STATE].reshape(b, T, M_GROUPS, M_STATE)
    Cm = act[..., M_INNER + M_GROUPS * M_STATE:].reshape(b, T, M_GROUPS, M_STATE)
    dt = jax.nn.softplus(dt_raw.astype(jnp.float32) + dt_bias.astype(jnp.float32))
    A = -jnp.exp(a_log.astype(jnp.float32))
    y, hT = _ssd(xs, dt, A, Bm, Cm, h0)
    y = y + d_skip.astype(jnp.float32)[:, None] * xs.astype(jnp.float32)
    y = y.reshape(b, T, M_INNER) * jax.nn.silu(z.astype(jnp.float32))
    return _rmsnorm(y, norm_w).astype(z.dtype), xcat[:, -(CONV_W - 1):], hT


def _hgrn2(q, f_logit, i, lb, S0):
    b, T = q.shape[0], q.shape[1]
    qh = jax.nn.silu(q.astype(jnp.float32)).reshape(b, T, HG_HEADS, HG_DK)
    fl = f_logit.astype(jnp.float32).reshape(b, T, HG_HEADS, HG_DK)
    lbh = lb.reshape(HG_HEADS, HG_DK)
    log_f = jnp.logaddexp(jnp.log(lbh), jnp.log1p(-lbh) + jax.nn.log_sigmoid(fl))
    kh = (1.0 - lbh) * jax.nn.sigmoid(-fl)
    ih = i.astype(jnp.float32).reshape(b, T, HG_HEADS, HG_DV)
    L = _blk(T, HG_CHUNK)
    nc = T // L

    def chunks(arr):
        return jnp.moveaxis(arr.reshape(b, nc, L, HG_HEADS, arr.shape[-1]), 1, 0)

    causal = jnp.tril(jnp.ones((L, L), bool))[None, :, :, None, None]

    def step(S, inp):
        qc, kc, ic, gc = inp
        bc = jnp.cumsum(gc, axis=1)
        dec = jnp.exp(jnp.where(causal, bc[:, :, None] - bc[:, None, :], -jnp.inf))
        att = jnp.einsum('bthk,btshk->bhts', qc, dec * kc[:, None])
        o = jnp.einsum('bhts,bshv->bthv', att, ic) + jnp.einsum('bthk,bhkv->bthv', qc * jnp.exp(bc), S)
        S = jnp.exp(bc[:, -1])[..., None] * S + jnp.einsum('bshk,bshv->bhkv', kc * jnp.exp(bc[:, -1:] - bc), ic)
        return S, o

    S_T, o = lax.scan(step, S0.astype(jnp.float32), (chunks(qh), chunks(kh), chunks(ih), chunks(log_f)))
    return jnp.moveaxis(o, 0, 1).reshape(b, T, HG_HEADS, HG_DV), S_T


def _mixer(x, prev, n_prev_valid, lb, p):
    k_prev, v_prev, conv_prev, ssm_prev, hg_prev = prev
    b, T = x.shape[0], x.shape[1]
    h = x @ p['w_in'] + p['b_in']
    q, k, v, mz, mxbc, mdt, hq, hf, hi, hg, gates = _split_cols(h)
    ya, nk, nv = _swa_attention(q, k.reshape(b, T, ATT_KV_HEADS, HEAD_DIM), v.reshape(b, T, ATT_KV_HEADS, HEAD_DIM),
                                k_prev, v_prev, n_prev_valid, p['att_sinks'])
    ym, nconv, nssm = _mamba2(mz, mxbc, mdt, conv_prev, ssm_prev, p['conv_w'], p['conv_b'], p['dt_bias'],
                              p['a_log'], p['d_skip'], p['ssm_norm_w'])
    oh, nhg = _hgrn2(hq, hf, hi, lb, hg_prev)
    yh = (_rmsnorm(oh, p['hg_norm_w']).reshape(b, T, HG_WIDTH) * jax.nn.silu(hg.astype(jnp.float32))).astype(x.dtype)
    g = jax.nn.sigmoid(gates)
    g_att, g_ssm, g_hg = g[..., :D_MODEL], g[..., D_MODEL:2 * D_MODEL], g[..., 2 * D_MODEL:]
    merged = g_att * (ya @ p['w_br_att']) + g_ssm * (ym @ p['w_br_ssm']) + g_hg * (yh @ p['w_br_hg'])
    return merged @ p['w_out'], (nk, nv, nconv, nssm.astype(x.dtype), nhg.astype(x.dtype))


def _layer(x, prev, n_prev_valid, lb, p):
    x = _layernorm(ALPHA * x + 0.5 * _swiglu(x, p['ffn1_wg'], p['ffn1_wu'], p['ffn1_wd']), p['ln1_g'], p['ln1_b'])
    y, new_state = _mixer(x, prev, n_prev_valid, lb, p)
    x = _layernorm(ALPHA * x + y, p['ln2_g'], p['ln2_b'])
    x = _layernorm(ALPHA * x + 0.5 * _swiglu(x, p['ffn2_wg'], p['ffn2_wu'], p['ffn2_wd']), p['ln3_g'], p['ln3_b'])
    return x, new_state


def setup_inputs(seed: int = 0) -> dict:
    key = jax.random.key(seed)
    keys = iter(jax.random.split(key, 48))

    def nrm(shape, scale):
        return scale * jax.random.normal(next(keys), shape, jnp.float32)

    def gain(shape):
        return 1.0 + nrm(shape, 0.1)

    att_w = ATT_HEADS * HEAD_DIM
    inp = {}
    inp['x_prompt'] = nrm((BATCH, SEQ, D_MODEL), 1.0)
    inp['x_sample'] = nrm((DEC_BATCH, DEC_SEQ, D_MODEL), 1.0)
    inp['cache_swa_k'] = nrm((DEPTH, DEC_BATCH, WINDOW, ATT_KV_HEADS, HEAD_DIM), 1.0)
    inp['cache_swa_v'] = nrm((DEPTH, DEC_BATCH, WINDOW, ATT_KV_HEADS, HEAD_DIM), 1.0)
    inp['state_conv'] = nrm((DEPTH, DEC_BATCH, CONV_W - 1, CONV_DIM), 1.0)
    inp['state_ssm'] = nrm((DEPTH, DEC_BATCH, M_HEADS, M_HEADDIM, M_STATE), 0.5)
    inp['state_hgrn'] = nrm((DEPTH, DEC_BATCH, HG_HEADS, HG_DK, HG_DV), 0.5)
    inp['ln1_g'] = gain((DEPTH, D_MODEL))
    inp['ln1_b'] = nrm((DEPTH, D_MODEL), 0.02)
    inp['ffn1_wg'] = nrm((DEPTH, D_MODEL, D_FF), D_MODEL ** -0.5)
    inp['ffn1_wu'] = nrm((DEPTH, D_MODEL, D_FF), D_MODEL ** -0.5)
    inp['ffn1_wd'] = nrm((DEPTH, D_FF, D_MODEL), BETA * D_FF ** -0.5)
    inp['w_in'] = nrm((DEPTH, D_MODEL, N_IN), D_MODEL ** -0.5)
    inp['b_in'] = nrm((DEPTH, N_IN), 0.02)
    inp['att_sinks'] = nrm((DEPTH, ATT_HEADS), 0.5)
    inp['conv_w'] = nrm((DEPTH, CONV_W, CONV_DIM), CONV_W ** -0.5)
    inp['conv_b'] = nrm((DEPTH, CONV_DIM), 0.02)
    dt0 = jnp.exp(jax.random.uniform(next(keys), (DEPTH, M_HEADS), jnp.float32, math.log(1e-3), math.log(1e-1)))
    inp['dt_bias'] = dt0 + jnp.log(-jnp.expm1(-dt0))
    inp['a_log'] = jnp.log(jax.random.uniform(next(keys), (DEPTH, M_HEADS), jnp.float32, 1.0, 16.0))
    inp['d_skip'] = gain((DEPTH, M_HEADS))
    inp['ssm_norm_w'] = gain((DEPTH, M_INNER))
    inp['hg_lb_logits'] = nrm((DEPTH, HG_WIDTH), 1.0)
    inp['hg_norm_w'] = gain((DEPTH, HG_DV))
    inp['w_br_att'] = nrm((DEPTH, att_w, D_MODEL), BETA * att_w ** -0.5)
    inp['w_br_ssm'] = nrm((DEPTH, M_INNER, D_MODEL), BETA * M_INNER ** -0.5)
    inp['w_br_hg'] = nrm((DEPTH, HG_WIDTH, D_MODEL), BETA * HG_WIDTH ** -0.5)
    inp['w_out'] = nrm((DEPTH, D_MODEL, D_MODEL), BETA * D_MODEL ** -0.5)
    inp['ln2_g'] = gain((DEPTH, D_MODEL))
    inp['ln2_b'] = nrm((DEPTH, D_MODEL), 0.02)
    inp['ffn2_wg'] = nrm((DEPTH, D_MODEL, D_FF), D_MODEL ** -0.5)
    inp['ffn2_wu'] = nrm((DEPTH, D_MODEL, D_FF), D_MODEL ** -0.5)
    inp['ffn2_wd'] = nrm((DEPTH, D_FF, D_MODEL), BETA * D_FF ** -0.5)
    inp['ln3_g'] = gain((DEPTH, D_MODEL))
    inp['ln3_b'] = nrm((DEPTH, D_MODEL), 0.02)
    return inp


def reference(x_prompt, x_sample, cache_swa_k, cache_swa_v, state_conv, state_ssm, state_hgrn,
              ln1_g, ln1_b, ffn1_wg, ffn1_wu, ffn1_wd, w_in, b_in, att_sinks, conv_w, conv_b,
              dt_bias, a_log, d_skip, ssm_norm_w, hg_lb_logits, hg_norm_w, w_br_att, w_br_ssm,
              w_br_hg, w_out, ln2_g, ln2_b, ffn2_wg, ffn2_wu, ffn2_wd, ln3_g, ln3_b):
    lb_all = jnp.cumsum(jax.nn.softmax(hg_lb_logits.astype(jnp.float32), axis=0), axis=0)
    lb_all = lb_all - lb_all[0]
    bp, dtype = x_prompt.shape[0], x_prompt.dtype
    zero_prev = (jnp.zeros((bp, WINDOW, ATT_KV_HEADS, HEAD_DIM), dtype),
                 jnp.zeros((bp, WINDOW, ATT_KV_HEADS, HEAD_DIM), dtype),
                 jnp.zeros((bp, CONV_W - 1, CONV_DIM), dtype),
                 jnp.zeros((bp, M_HEADS, M_HEADDIM, M_STATE), dtype),
                 jnp.zeros((bp, HG_HEADS, HG_DK, HG_DV), dtype))
    n_past_valid = min(WINDOW, PAST_LEN)
    y_prompt, y_sample = x_prompt, x_sample
    p_states, s_states = [], []
    for l in range(DEPTH):
        p = {'ln1_g': ln1_g[l], 'ln1_b': ln1_b[l], 'ffn1_wg': ffn1_wg[l], 'ffn1_wu': ffn1_wu[l],
             'ffn1_wd': ffn1_wd[l], 'w_in': w_in[l], 'b_in': b_in[l], 'att_sinks': att_sinks[l],
             'conv_w': conv_w[l], 'conv_b': conv_b[l], 'dt_bias': dt_bias[l], 'a_log': a_log[l],
             'd_skip': d_skip[l], 'ssm_norm_w': ssm_norm_w[l], 'hg_norm_w': hg_norm_w[l],
             'w_br_att': w_br_att[l], 'w_br_ssm': w_br_ssm[l], 'w_br_hg': w_br_hg[l], 'w_out': w_out[l],
             'ln2_g': ln2_g[l], 'ln2_b': ln2_b[l], 'ffn2_wg': ffn2_wg[l], 'ffn2_wu': ffn2_wu[l],
             'ffn2_wd': ffn2_wd[l], 'ln3_g': ln3_g[l], 'ln3_b': ln3_b[l]}
        y_prompt, ps = _layer(y_prompt, zero_prev, 0, lb_all[l], p)
        s_prev = (cache_swa_k[l], cache_swa_v[l], state_conv[l], state_ssm[l], state_hgrn[l])
        y_sample, ss = _layer(y_sample, s_prev, n_past_valid, lb_all[l], p)
        p_states.append(ps)
        s_states.append(ss)
    p_swa_k, p_swa_v, p_conv, p_ssm, p_hgrn = [jnp.stack(t) for t in zip(*p_states)]
    s_swa_k, s_swa_v, s_conv, s_ssm, s_hgrn = [jnp.stack(t) for t in zip(*s_states)]
    return (y_prompt, y_sample, p_swa_k, p_swa_v, p_conv, p_ssm, p_hgrn, s_swa_k, s_swa_v, s_conv, s_ssm, s_hgrn)
```

```cpp
#include <hip/hip_runtime.h>
#include <hip/hip_cooperative_groups.h>
#include <cstdio>
namespace cg = cooperative_groups;

namespace pg8 {
#define PG8_LAS __attribute__((address_space(3)))
typedef unsigned short bf16_t;
typedef short bf16x8 __attribute__((ext_vector_type(8)));
typedef float f32x4 __attribute__((ext_vector_type(4)));
typedef unsigned u32x4 __attribute__((ext_vector_type(4)));
typedef unsigned u32x2 __attribute__((ext_vector_type(2)));
constexpr int BM = 256, BK = 64, HALF = 128, HTB = HALF * BK * 2, STAGE_BYTES = 8 * HTB, NXCD = 8, WGM = 8;

__host__ __device__ __forceinline__ int lds_byte(int r, int c) { const int st = (r >> 4) * 2 + (c >> 5), rr = r & 15, cc = c & 31, ob = rr * 64 + cc * 2; return st * 1024 + (ob ^ (((ob >> 9) & 1) << 5)); }
__host__ __device__ __forceinline__ void stage_rc(int b, int& R, int& C) { const int st = b / 1024, sb = b % 1024, swz = sb ^ (((sb >> 9) & 1) << 5); R = (st >> 1) * 16 + swz / 64; C = (st & 1) * 32 + (swz % 64) / 2; }
__host__ __device__ __forceinline__ int perm32(int rho) { const int n = rho >> 4, i = rho & 15; return 8 * (i >> 2) + 4 * n + (i & 3); }

struct Unit { int pm, pn, z; };
struct Gemm { const bf16_t* A; const bf16_t* Bt; int M, N, K; size_t zA, zB; };

struct StaticOrder {
    int nM, nN, nwg, G, c;
    __device__ void init(int M, int N, int G_, int c_) { nM = M / BM; nN = N / BM; nwg = nM * nN; G = G_; c = c_; }
    __device__ bool next(int i, Unit& u) const {
        const long L = (long)i * G + c; if (L >= nwg) return false;
        int wgid = (int)L; { const int q = nwg / NXCD, r = nwg % NXCD, xcd = wgid % NXCD, off = wgid / NXCD; wgid = (xcd < r ? xcd * (q + 1) : r * (q + 1) + (xcd - r) * q) + off; }
        const int nig = WGM * nN, gid = wgid / nig, fm = gid * WGM, gsz = (nM - fm) < WGM ? (nM - fm) : WGM;
        u.pm = fm + ((wgid % nig) % gsz); u.pn = (wgid % nig) / gsz; u.z = 0; return true;
    }
};
struct TripleOrder : StaticOrder {
    __device__ bool next(int i, Unit& u) const { const int k = i / 3; if (!StaticOrder::next(k, u)) return false; u.z = i - 3 * k; return true; }
};

__device__ __forceinline__ unsigned cvt_pk_bf16(float lo, float hi) { unsigned r; asm volatile("v_cvt_pk_bf16_f32 %0, %1, %2" : "=v"(r) : "v"(lo), "v"(hi)); return r; }

template <class Epi, class Sched>
__device__ __forceinline__ void gemm_phase(PG8_LAS unsigned char* lds, const Gemm g, const Sched& S, const Epi& E, const int tid) {
    const int wid = __builtin_amdgcn_readfirstlane(tid >> 6), lane = tid & 63, wr = wid >> 2, wc = wid & 3, fr = lane & 15, fq = lane >> 4;
    const int K = g.K, nt = K / BK;
    unsigned voffA[2], voffB[2];
#pragma unroll
    for (int i = 0; i < 2; ++i) { int R, C; stage_rc(tid * 16 + i * 8192, R, C); const int Rb = Epi::PERM ? ((R & ~31) + perm32(R & 31)) : R;
        voffA[i] = (unsigned)(R * K + C) * 2u; voffB[i] = (unsigned)(Rb * K + C) * 2u; }
    const size_t kstep = (size_t)(BK * 2);
    const size_t hstep = (size_t)HALF * K * 2;
    const size_t tstep = 2 * hstep;
    const unsigned ldsw = (unsigned)wid * 1024u;
    const int aoff = lds_byte(wr * 64 + fr, fq * 8), boff = lds_byte(wc * 32 + fr, fq * 8);
#define PG8_SA(b, h) (((b) * 2 + (h)) * HTB)
#define PG8_SB(b, h) ((4 + (b) * 2 + (h)) * HTB)
#define PG8_STAGE(bufoff, gbase, voff) do { _Pragma("unroll") for (int _i = 0; _i < 2; ++_i) \
        __builtin_amdgcn_global_load_lds((const unsigned*)((const char*)(gbase) + (voff)[_i]), (PG8_LAS unsigned*)(lds + (bufoff) + ldsw + _i * 8192), 16, 0, 0); } while (0)
#define PG8_LDA(dst, b, h) do { _Pragma("unroll") for (int m = 0; m < 4; ++m) _Pragma("unroll") for (int k = 0; k < 2; ++k) dst[m][k] = *(const PG8_LAS bf16x8*)(lds + PG8_SA(b, h) + aoff + m * 2048 + k * 1024); } while (0)
#define PG8_LDB(dst, b, h) do { _Pragma("unroll") for (int n = 0; n < 2; ++n) _Pragma("unroll") for (int k = 0; k < 2; ++k) dst[n][k] = *(const PG8_LAS bf16x8*)(lds + PG8_SB(b, h) + boff + n * 2048 + k * 1024); } while (0)
#define PG8_MMA(ai, bj, At, Bt) do { __builtin_amdgcn_s_setprio(1); _Pragma("unroll") for (int m = 0; m < 4; ++m) _Pragma("unroll") for (int n = 0; n < 2; ++n) _Pragma("unroll") for (int k = 0; k < 2; ++k) \
        acc[ai][bj][m][n] = __builtin_amdgcn_mfma_f32_16x16x32_bf16(Bt[n][k], At[m][k], acc[ai][bj][m][n], 0, 0, 0); __builtin_amdgcn_s_setprio(0); } while (0)
#define PG8_WAIT_V(n) asm volatile("s_waitcnt vmcnt(" #n ")" ::: "memory")
#define PG8_WAIT_L(n) asm volatile("s_waitcnt lgkmcnt(" #n ")" ::: "memory")
#define PG8_BAR __builtin_amdgcn_s_barrier()
#define PG8_SCHED __builtin_amdgcn_sched_barrier(0)
    Unit cur, nxt; int ui = 0;
    if (!S.next(0, cur)) return;
    f32x4 acc[2][2][4][2];
#pragma unroll
    for (int a = 0; a < 2; ++a)
#pragma unroll
        for (int b = 0; b < 2; ++b)
#pragma unroll
            for (int m = 0; m < 4; ++m)
#pragma unroll
                for (int n = 0; n < 2; ++n) acc[a][b][m][n] = (f32x4){0.f, 0.f, 0.f, 0.f};
    bf16x8 At[4][2], B0[2][2], B1[2][2];
    const char* cA = (const char*)g.A + (size_t)cur.z * g.zA + (size_t)cur.pm * tstep; const char* cB = (const char*)g.Bt + (size_t)cur.z * g.zB + (size_t)cur.pn * tstep;
    PG8_STAGE(PG8_SB(0, 0), cB, voffB); PG8_STAGE(PG8_SA(0, 0), cA, voffA); PG8_STAGE(PG8_SB(0, 1), cB + hstep, voffB); PG8_STAGE(PG8_SA(0, 1), cA + hstep, voffA);
    if (wr == 1) PG8_BAR;
    PG8_WAIT_V(4); PG8_BAR;
    PG8_STAGE(PG8_SB(1, 0), cB + kstep, voffB); PG8_STAGE(PG8_SA(1, 0), cA + kstep, voffA); PG8_STAGE(PG8_SB(1, 1), cB + hstep + kstep, voffB);
    PG8_WAIT_V(6); PG8_BAR;
    for (;;) {
        const bool has_next = S.next(ui + 1, nxt);
        const char* nA = has_next ? (const char*)g.A + (size_t)nxt.z * g.zA + (size_t)nxt.pm * tstep : cA; const char* nB = has_next ? (const char*)g.Bt + (size_t)nxt.z * g.zB + (size_t)nxt.pn * tstep : cB;
        for (int t = 0; t < nt; t += 2) {
            const bool last = (t == nt - 2);
            const char* a1 = cA + (size_t)(t + 1) * kstep;
            const char* a2 = last ? nA : cA + (size_t)(t + 2) * kstep; const char* b2 = last ? nB : cB + (size_t)(t + 2) * kstep;
            const char* a3 = a2 + kstep; const char* b3 = b2 + kstep;
            PG8_LDB(B0, 0, 0); PG8_SCHED; PG8_LDA(At, 0, 0); PG8_STAGE(PG8_SA(1, 1), a1 + hstep, voffA);
            PG8_WAIT_L(8); PG8_BAR; PG8_WAIT_L(0); PG8_MMA(0, 0, At, B0); PG8_BAR; PG8_SCHED;
            PG8_LDB(B1, 0, 1); PG8_STAGE(PG8_SB(0, 0), b2, voffB);
            PG8_BAR; PG8_WAIT_L(0); PG8_MMA(0, 1, At, B1); PG8_BAR;
            PG8_LDA(At, 0, 1); PG8_STAGE(PG8_SA(0, 0), a2, voffA);
            PG8_BAR; PG8_WAIT_L(0); PG8_MMA(1, 0, At, B0); PG8_BAR; PG8_SCHED;
            PG8_STAGE(PG8_SB(0, 1), b2 + hstep, voffB);
            PG8_WAIT_V(6); PG8_BAR; PG8_MMA(1, 1, At, B1); PG8_BAR;
            PG8_LDB(B0, 1, 0); PG8_SCHED; PG8_LDA(At, 1, 0); PG8_STAGE(PG8_SA(0, 1), a2 + hstep, voffA);
            PG8_WAIT_L(8); PG8_BAR; PG8_WAIT_L(0); PG8_MMA(0, 0, At, B0); PG8_BAR; PG8_SCHED;
            PG8_LDB(B1, 1, 1); PG8_STAGE(PG8_SB(1, 0), b3, voffB);
            PG8_BAR; PG8_WAIT_L(0); PG8_MMA(0, 1, At, B1); PG8_BAR;
            PG8_LDA(At, 1, 1); PG8_STAGE(PG8_SA(1, 0), a3, voffA);
            PG8_BAR; PG8_WAIT_L(0); PG8_MMA(1, 0, At, B0); PG8_BAR; PG8_SCHED;
            PG8_STAGE(PG8_SB(1, 1), b3 + hstep, voffB);
            PG8_WAIT_V(6); PG8_BAR; PG8_MMA(1, 1, At, B1); PG8_BAR;
        }
        E(acc, cur, wr, wc, fr, fq);
        if (!has_next) break;
#pragma unroll
        for (int a = 0; a < 2; ++a)
#pragma unroll
            for (int b = 0; b < 2; ++b)
#pragma unroll
                for (int m = 0; m < 4; ++m)
#pragma unroll
                    for (int n = 0; n < 2; ++n) acc[a][b][m][n] = (f32x4){0.f, 0.f, 0.f, 0.f};
        cur = nxt; cA = nA; cB = nB; ++ui;
    }
    PG8_WAIT_V(0);
    if (wr == 0) PG8_BAR;
    PG8_BAR;
#undef PG8_SA
#undef PG8_SB
#undef PG8_STAGE
#undef PG8_LDA
#undef PG8_LDB
#undef PG8_MMA
#undef PG8_WAIT_V
#undef PG8_WAIT_L
#undef PG8_BAR
#undef PG8_SCHED
}
}

using pg8::bf16_t; using pg8::bf16x8; using pg8::f32x4; using pg8::u32x4; using pg8::u32x2; using pg8::cvt_pk_bf16;

constexpr int DM = 1024, DFF = 2816, NIN = 7176, NH = 7424;
constexpr int TP = 16384, MS = 128, MR = TP + MS, MP = 16640, SEQ = 4096, NB = 4;
constexpr int NTHR = 512;
constexpr float ALPHA = 1.6817928305074290861f;
constexpr int LDS_GEMM = 131072;
constexpr int LDS_BYTES = 131072 + 16;
constexpr int HC_Q = 0, HC_K = 512, HC_V = 640, HC_Z = 768, HC_XBC = 1280, HC_HQ = 2048, HC_HF = 2560, HC_HI = 3072, HC_HG = 3584, HC_GATE = 4096, HC_DT = 7168;

constexpr size_t al256(size_t x) { return (x + 255) & ~(size_t)255; }
constexpr size_t WS_WGU1 = 0;
constexpr size_t WS_WD1 = WS_WGU1 + (size_t)5632 * 1024 * 2;
constexpr size_t WS_WIN = WS_WD1 + (size_t)1024 * 2816 * 2;
constexpr size_t WS_WBR = WS_WIN + (size_t)NH * 1024 * 2;
constexpr size_t WS_WOUT = WS_WBR + (size_t)3 * 1024 * 512 * 2;
constexpr size_t WS_WGU2 = WS_WOUT + (size_t)1024 * 1024 * 2;
constexpr size_t WS_WD2 = WS_WGU2 + (size_t)5632 * 1024 * 2;
constexpr size_t WS_BIAS = WS_WD2 + (size_t)1024 * 2816 * 2;
constexpr size_t WS_X = al256(WS_BIAS + (size_t)NH * 4);
constexpr size_t WS_XB = WS_X + (size_t)MP * 1024 * 4;
constexpr size_t WS_HB = WS_XB + (size_t)MP * 1024 * 2;
constexpr size_t WS_ACT = WS_HB + (size_t)MP * NH * 2;
constexpr size_t WS_ACUM = WS_ACT + (size_t)TP * 768 * 2;
constexpr size_t WS_MERGED = WS_ACUM + (size_t)TP * 8 * 4;
constexpr size_t WS_YSSD = WS_MERGED;
constexpr size_t WS_OHG = WS_MERGED + (size_t)TP * 512 * 4;
constexpr size_t WS_CS = WS_MERGED + (size_t)MP * 1024 * 4;
constexpr size_t WS_DECS = WS_CS + (size_t)4 * 64 * 8 * 4096 * 4;
constexpr size_t WS_KC = WS_DECS + (size_t)4 * 64 * 8 * 4;
constexpr size_t WS_DECH = WS_KC + (size_t)4 * 4 * 64 * 16384 * 4;
constexpr size_t WS_QE = WS_DECH + (size_t)4 * 4 * 64 * 128 * 4;
constexpr size_t WS_YA = WS_QE + (size_t)TP * 512 * 2;
constexpr size_t WS_YM = WS_YA + (size_t)MP * 512 * 2;
constexpr size_t WS_YH = WS_YM + (size_t)MP * 512 * 2;
constexpr size_t WS_MB = WS_YH + (size_t)MP * 512 * 2;
constexpr size_t WS_BAR = WS_MB + (size_t)MP * 1024 * 2;
constexpr size_t WS_END = WS_BAR + (size_t)3456 * 4;

constexpr size_t O_YP = 0, O_YS = 16777216, O_PK = 16908288, O_PV = 17170432, O_PC = 17432576, O_PSSM = 17469440, O_PHG = 17993728,
                 O_SK = 19042304, O_SV = 27430912, O_SC = 35819520, O_SSSM = 36999168, O_SHG = 53776384, O_END = 87330816;

struct Params { const float* in[34]; float* out; unsigned char* ws; };
enum { I_XP = 0, I_XS, I_CK, I_CV, I_SCONV, I_SSSM, I_SHG, I_LN1G, I_LN1B, I_F1G, I_F1U, I_F1D, I_WIN, I_BIN, I_SINK, I_CONVW, I_CONVB, I_DTB, I_ALOG, I_DSKIP,
       I_SNW, I_LBL, I_HNW, I_WBA, I_WBS, I_WBH, I_WOUT, I_LN2G, I_LN2B, I_F2G, I_F2U, I_F2D, I_LN3G, I_LN3B };

__device__ __forceinline__ float bf2f(bf16_t v) { return __uint_as_float(((unsigned)v) << 16); }
__device__ __forceinline__ bf16_t f2bf(float f) { unsigned u = __float_as_uint(f); u += 0x7FFFu + ((u >> 16) & 1u); return (bf16_t)(u >> 16); }
__device__ __forceinline__ unsigned pk_bf16_c(float lo, float hi) { return (unsigned)f2bf(lo) | ((unsigned)f2bf(hi) << 16); }
__device__ __forceinline__ float sigmoidf_(float x) { return __builtin_amdgcn_rcpf(1.0f + __expf(-x)); }
__device__ __forceinline__ float siluf_(float x) { return x * __builtin_amdgcn_rcpf(1.0f + __expf(-x)); }
__device__ __forceinline__ float siluf_fast(float x) { return x * __builtin_amdgcn_rcpf(1.0f + __expf(-x)); }
__device__ __forceinline__ float softplusf_(float x) { const float e = __expf(x); return x > 20.f ? x : (x < -8.f ? e * (1.0f - 0.5f * e) : __logf(1.0f + e)); }
__device__ __forceinline__ void unpack8(const u32x4 w, float* f) {
    f[0] = __uint_as_float(w.x << 16); f[1] = __uint_as_float(w.x & 0xFFFF0000u); f[2] = __uint_as_float(w.y << 16); f[3] = __uint_as_float(w.y & 0xFFFF0000u);
    f[4] = __uint_as_float(w.z << 16); f[5] = __uint_as_float(w.z & 0xFFFF0000u); f[6] = __uint_as_float(w.w << 16); f[7] = __uint_as_float(w.w & 0xFFFF0000u); }
__device__ __forceinline__ float quad16_sum(float v) { v += __shfl_xor(v, 1); v += __shfl_xor(v, 2); v += __shfl_xor(v, 4); v += __shfl_xor(v, 8); return v; }
__device__ __forceinline__ float quad16_max(float v) { v = fmaxf(v, __shfl_xor(v, 1)); v = fmaxf(v, __shfl_xor(v, 2)); v = fmaxf(v, __shfl_xor(v, 4)); v = fmaxf(v, __shfl_xor(v, 8)); return v; }
__device__ __forceinline__ float wave_sum(float v) { v += __shfl_xor(v, 1); v += __shfl_xor(v, 2); v += __shfl_xor(v, 4); v += __shfl_xor(v, 8); v += __shfl_xor(v, 16); v += __shfl_xor(v, 32); return v; }
__device__ __forceinline__ float wave_max(float v) { v = fmaxf(v, __shfl_xor(v, 1)); v = fmaxf(v, __shfl_xor(v, 2)); v = fmaxf(v, __shfl_xor(v, 4)); v = fmaxf(v, __shfl_xor(v, 8)); v = fmaxf(v, __shfl_xor(v, 16)); v = fmaxf(v, __shfl_xor(v, 32)); return v; }
__device__ __forceinline__ float wave_incl_scan(float v, int lane) {
#pragma unroll
    for (int d = 1; d < 64; d <<= 1) { float o = __shfl_up(v, d); if (lane >= d) v += o; }
    return v; }
__device__ __forceinline__ f32x4 mma16(const bf16_t* A, int lda, const bf16_t* Bt, int ldb, int K, f32x4 acc, int lane) {
    const int r = lane & 15, q = lane >> 4;
    const bf16_t* ap = A + r * lda + q * 8; const bf16_t* bp = Bt + r * ldb + q * 8;
    for (int k0 = 0; k0 < K; k0 += 32) { const bf16x8 a = *(const bf16x8*)(ap + k0); const bf16x8 b = *(const bf16x8*)(bp + k0); acc = __builtin_amdgcn_mfma_f32_16x16x32_bf16(a, b, acc, 0, 0, 0); }
    return acc; }
__device__ __forceinline__ float lb_of(const float* lbl, int l, int ch) {
    const float x0 = lbl[ch], x1 = lbl[512 + ch], x2 = lbl[1024 + ch], x3 = lbl[1536 + ch];
    const float m = fmaxf(fmaxf(x0, x1), fmaxf(x2, x3));
    const float e0 = __expf(x0 - m), e1 = __expf(x1 - m), e2 = __expf(x2 - m), e3 = __expf(x3 - m);
    const float s = e0 + e1 + e2 + e3;
    float acc = 0.f; if (l >= 1) acc += e1; if (l >= 2) acc += e2; if (l >= 3) acc += e3;
    return acc / s; }

struct EpiSwiglu {
    static constexpr bool PERM = true;
    bf16_t* H;
    __device__ __forceinline__ void operator()(const f32x4 (&acc)[2][2][4][2], const pg8::Unit& u, int wr, int wc, int fr, int fq) const {
        const int row0 = u.pm * 256 + wr * 64 + fr, col0 = u.pn * 128 + wc * 32 + 8 * fq;
#pragma unroll
        for (int ai = 0; ai < 2; ++ai)
#pragma unroll
            for (int m = 0; m < 4; ++m) {
                bf16_t* rowp = H + (size_t)(row0 + ai * 128 + m * 16) * DFF + col0;
                float h[8];
#pragma unroll
                for (int n = 0; n < 2; ++n)
#pragma unroll
                    for (int j = 0; j < 4; ++j) h[n * 4 + j] = siluf_fast(acc[ai][0][m][n][j]) * acc[ai][1][m][n][j];
                u32x4 w; w.x = cvt_pk_bf16(h[0], h[1]); w.y = cvt_pk_bf16(h[2], h[3]); w.z = cvt_pk_bf16(h[4], h[5]); w.w = cvt_pk_bf16(h[6], h[7]);
                *(u32x4*)rowp = w; __builtin_amdgcn_sched_barrier(0); }
    }
};
struct EpiResid {
    static constexpr bool PERM = true;
    float* X; const bf16_t* XB; float scale;
    __device__ __forceinline__ void operator()(const f32x4 (&acc)[2][2][4][2], const pg8::Unit& u, int wr, int wc, int fr, int fq) const {
        const int row0 = u.pm * 256 + wr * 64 + fr, col0 = u.pn * 256 + wc * 32 + 8 * fq;
#pragma unroll
        for (int ai = 0; ai < 2; ++ai)
#pragma unroll
            for (int m = 0; m < 4; ++m) { const size_t ro = (size_t)(row0 + ai * 128 + m * 16) * DM + col0;
#pragma unroll
                for (int bj = 0; bj < 2; ++bj) { float b[8]; unpack8(*(const u32x4*)(XB + ro + bj * 128), b);
                    const f32x4 x0 = (f32x4){b[0], b[1], b[2], b[3]}, x1 = (f32x4){b[4], b[5], b[6], b[7]};
                    *(f32x4*)(X + ro + bj * 128) = x0 * ALPHA + acc[ai][bj][m][0] * scale;
                    *(f32x4*)(X + ro + bj * 128 + 4) = x1 * ALPHA + acc[ai][bj][m][1] * scale; } }
    }
};
struct EpiBiasBf16 {
    static constexpr bool PERM = true;
    bf16_t* O; const float* bias;
    __device__ __forceinline__ void operator()(const f32x4 (&acc)[2][2][4][2], const pg8::Unit& u, int wr, int wc, int fr, int fq) const {
        const int row0 = u.pm * 256 + wr * 64 + fr, col0 = u.pn * 256 + wc * 32 + 8 * fq;
        f32x4 bv[2][2];
#pragma unroll
        for (int bj = 0; bj < 2; ++bj)
#pragma unroll
            for (int n = 0; n < 2; ++n) bv[bj][n] = *(const f32x4*)(bias + col0 + bj * 128 + 4 * n);
#pragma unroll
        for (int ai = 0; ai < 2; ++ai)
#pragma unroll
            for (int m = 0; m < 4; ++m) { bf16_t* rowp = O + (size_t)(row0 + ai * 128 + m * 16) * NH + col0;
#pragma unroll
                for (int bj = 0; bj < 2; ++bj) { const f32x4 v0 = acc[ai][bj][m][0] + bv[bj][0], v1 = acc[ai][bj][m][1] + bv[bj][1];
                    u32x4 w; w.x = cvt_pk_bf16(v0[0], v0[1]); w.y = cvt_pk_bf16(v0[2], v0[3]); w.z = cvt_pk_bf16(v1[0], v1[1]); w.w = cvt_pk_bf16(v1[2], v1[3]);
                    *(u32x4*)(rowp + bj * 128) = w; } }
    }
};
struct EpiMergeZ {
    static constexpr bool PERM = true;
    bf16_t* MB; const bf16_t* HBp;
    __device__ __forceinline__ void operator()(const f32x4 (&acc)[2][2][4][2], const pg8::Unit& u, int wr, int wc, int fr, int fq) const {
        const int row0 = u.pm * 256 + wr * 64 + fr, col0 = u.pn * 256 + wc * 32 + 8 * fq, gcol = HC_GATE + 1024 * u.z; const bool rmw = u.z != 0;
#pragma unroll
        for (int ai = 0; ai < 2; ++ai)
#pragma unroll
            for (int m = 0; m < 4; ++m) { const size_t row = (size_t)(row0 + ai * 128 + m * 16);
#pragma unroll
                for (int bj = 0; bj < 2; ++bj) { const int c = col0 + bj * 128;
                    float gv[8]; unpack8(*(const u32x4*)(HBp + row * NH + gcol + c), gv);
                    float v[8];
#pragma unroll
                    for (int j = 0; j < 4; ++j) { v[j] = sigmoidf_(gv[j]) * acc[ai][bj][m][0][j]; v[4 + j] = sigmoidf_(gv[4 + j]) * acc[ai][bj][m][1][j]; }
                    u32x4* mp = (u32x4*)(MB + row * DM + c);
                    if (rmw) { float ov[8]; unpack8(*mp, ov);
#pragma unroll
                        for (int j = 0; j < 8; ++j) v[j] += ov[j]; }
                    u32x4 w; w.x = cvt_pk_bf16(v[0], v[1]); w.y = cvt_pk_bf16(v[2], v[3]); w.z = cvt_pk_bf16(v[4], v[5]); w.w = cvt_pk_bf16(v[6], v[7]); *mp = w; } }
    }
};

#define XB_TMO      128
#define XB_XCNT(j)  (256  + 64 * (j))
#define XB_XSUB(j)  (1280 + 64 * (j))
#define XB_XGEN(j)  (2304 + 64 * (j))
#define XB_TOP      3328
#define XB_TOPGEN   3392
#define XCD_BAR_WORDS 3456
#define XB_SPIN_CAP (1u << 18)
#define LAS __attribute__((address_space(3)))
__device__ __forceinline__ unsigned xb_ld(unsigned* p)              { return __hip_atomic_load(p, __ATOMIC_RELAXED, __HIP_MEMORY_SCOPE_AGENT); }
__device__ __forceinline__ unsigned xb_add(unsigned* p, unsigned v) { return __hip_atomic_fetch_add(p, v, __ATOMIC_RELAXED, __HIP_MEMORY_SCOPE_AGENT); }
__device__ __forceinline__ unsigned xb_xcc_id() { return (unsigned)__builtin_amdgcn_s_getreg((3 << 11) | 20) & 0xFu; }
#define XB_SPIN(cond, bar) do { unsigned _sp = 0; while (cond) { __builtin_amdgcn_s_sleep(1); \
    if ((++_sp & 255u) == 0u) { if (xb_ld(&(bar)[XB_TMO])) break; if (_sp > XB_SPIN_CAP) { atomicAdd(&(bar)[XB_TMO], 1u); break; } } } } while (0)
struct XcdBarrier { unsigned* bar; unsigned x; volatile LAS unsigned* st; };
__device__ __forceinline__ XcdBarrier xcd_barrier_post(unsigned* bar, volatile LAS unsigned* st) {
    XcdBarrier b; b.bar = bar; b.x = xb_xcc_id(); b.st = st;
    if (threadIdx.x == 0) (void)xb_add(&bar[XB_XCNT(b.x)], 1u);
    return b;
}
__device__ __forceinline__ void xcd_barrier_complete(unsigned* bar, unsigned x, unsigned& nloc, unsigned& nx) {
    const unsigned G = gridDim.x * gridDim.y * gridDim.z;
    unsigned sum, cnt, mine, sp = 0u;
    for (;;) {
        sum = 0u; cnt = 0u; mine = 0u;
#pragma unroll
        for (unsigned j = 0; j < 16; ++j) { const unsigned c = xb_ld(&bar[XB_XCNT(j)]); sum += c; cnt += (c > 0u) ? 1u : 0u; mine = (j == x) ? c : mine; }
        if (sum == G) break;
        __builtin_amdgcn_s_sleep(1);
        if ((++sp & 255u) == 0u) { if (xb_ld(&bar[XB_TMO])) break; if (sp > XB_SPIN_CAP) { atomicAdd(&bar[XB_TMO], 1u); break; } }
    }
    nloc = mine > 0u ? mine : 1u; nx = cnt > 0u ? cnt : 1u;
}
__device__ __forceinline__ void xcd_barrier(const XcdBarrier& b) {
    asm volatile("s_waitcnt vmcnt(0)" ::: "memory");
    __syncthreads();
    if (threadIdx.x == 0) {
        unsigned* bar = b.bar;
        __builtin_amdgcn_s_waitcnt(0);
        unsigned nloc = b.st[0], nx = b.st[1];
        if (nloc == 0u) { xcd_barrier_complete(bar, b.x, nloc, nx); b.st[0] = nloc; b.st[1] = nx; }
        const unsigned old = xb_add(&bar[XB_XSUB(b.x)], 1u);
        const unsigned gen = old / nloc;
        if (old + 1u == (gen + 1u) * nloc) {
            __builtin_amdgcn_fence(__ATOMIC_RELEASE, "agent");
            asm volatile("s_waitcnt vmcnt(0)" ::: "memory");
            const unsigned og = xb_add(&bar[XB_TOP], 1u);
            const unsigned tg = og / nx;
            if (og + 1u == (tg + 1u) * nx) xb_add(&bar[XB_TOPGEN], 1u);
            else XB_SPIN(xb_ld(&bar[XB_TOPGEN]) == tg, bar);
            __builtin_amdgcn_fence(__ATOMIC_ACQUIRE, "agent");
            xb_add(&bar[XB_XGEN(b.x)], 1u);
            asm volatile("s_waitcnt vmcnt(0)" ::: "memory");
        } else {
            XB_SPIN(xb_ld(&bar[XB_XGEN(b.x)]) == gen, bar);
            __builtin_amdgcn_fence(__ATOMIC_ACQUIRE, "agent");
            asm volatile("s_waitcnt vmcnt(0)" ::: "memory");
        }
    }
    __syncthreads();
}

struct Frame {
    const Params* p; unsigned char* ws; unsigned char* sm; int tid, lane, wave, G, bid, l;
    __device__ __forceinline__ const float* in(int i) const { return p->in[i]; }
    template <class T> __device__ __forceinline__ T* w(size_t off) const { return (T*)(ws + off); }
};

__device__ __forceinline__ int win_map(int n) { return n < 2048 ? n : (n < 4096 ? n + 8 : (n < 7168 ? n + 8 : (n < 7176 ? n - 7168 + 2048 : -1))); }
__device__ __forceinline__ void tconv_task(const Frame& F, const float* src, const float* src2, int Nsrc, int K, bf16_t* dst, int n0, int k0, int mode, const float* g, const float* b, float* cs, float* bw) {
    float* tile = (float*)F.sm;
    float* colsum = tile + 4 * 64 * 65;
    __syncthreads();
    if (F.tid < 128) colsum[F.tid] = 0.f;
    const int n4 = (F.tid & 15) * 4, n = n0 + n4;
    const float* sp = src; int col = n;
    if (mode == 1) { const int t = n >> 8, r = n & 255; sp = (r < 128) ? src : src2; col = t * 128 + (r & 127); }
    else if (mode == 2) col = win_map(n);
    f32x4 v[4][2];
#pragma unroll
    for (int j = 0; j < 4; ++j)
#pragma unroll
        for (int i = 0; i < 2; ++i) { const int kk = (F.tid >> 4) + i * 32;
            v[j][i] = (col >= 0) ? __builtin_nontemporal_load((const f32x4*)(sp + (size_t)(k0 + j * 64 + kk) * Nsrc + col)) : (f32x4){0.f, 0.f, 0.f, 0.f}; }
    __syncthreads();
    f32x4 csa = (f32x4){0.f, 0.f, 0.f, 0.f}, bwa = csa;
#pragma unroll
    for (int j = 0; j < 4; ++j)
#pragma unroll
        for (int i = 0; i < 2; ++i) { const int kk = (F.tid >> 4) + i * 32, k = k0 + j * 64 + kk; f32x4 w = v[j][i];
            if (cs) { const float gk = g ? g[k] : 1.f, bk = b ? b[k] : 0.f; bwa += w * bk; w *= gk;
#pragma unroll
                for (int c = 0; c < 4; ++c) { w[c] = bf2f(f2bf(w[c])); } csa += w; }
#pragma unroll
            for (int c = 0; c < 4; ++c) tile[(j * 64 + kk) * 65 + n4 + c] = w[c]; }
    if (cs) {
#pragma unroll
        for (int c = 0; c < 4; ++c) { float a = csa[c], bb = bwa[c]; a += __shfl_xor(a, 16); a += __shfl_xor(a, 32); bb += __shfl_xor(bb, 16); bb += __shfl_xor(bb, 32);
            if (F.lane < 16) { atomicAdd(&colsum[(n4 + c) * 2], a); atomicAdd(&colsum[(n4 + c) * 2 + 1], bb); } } }
    __syncthreads();
    for (int e = F.tid; e < 64 * 128; e += NTHR) { const int nn = e >> 7, kp = (e & 127) * 2;
        *(unsigned*)(dst + (size_t)(n0 + nn) * K + k0 + kp) = cvt_pk_bf16(tile[kp * 65 + nn], tile[(kp + 1) * 65 + nn]); }
    if (cs && F.tid < 64) { atomicAdd(cs + n0 + F.tid, colsum[F.tid * 2]); atomicAdd(bw + n0 + F.tid, colsum[F.tid * 2 + 1]); }
}
constexpr int CT_E0 = 352, CT_E1 = 528, CT_E2 = 992, CT_E3 = 1088, CT_E4 = 1152, CT_E5 = 1504, CT_E6 = 1680, CT_SPLIT = 674;
__device__ __forceinline__ void convert_tasks(const Frame& F, int lo, int hi, int start, int stride) {
    const int l = F.l;
    const int nt3 = (1024 / 64) * 2;
    const int e0 = CT_E0, e1 = CT_E1, e2 = CT_E2, e3 = CT_E3, e4 = CT_E4, e5 = CT_E5;
    for (int t = lo + start; t < hi; t += stride) {
        if (t < e0) tconv_task(F, F.in(I_F1G) + (size_t)l * 1024 * DFF, F.in(I_F1U) + (size_t)l * 1024 * DFF, DFF, 1024, F.w<bf16_t>(WS_WGU1), (t >> 2) * 64, (t & 3) * 256, 1, nullptr, nullptr, nullptr, nullptr);
        else if (t < e1) { const int u = t - e0; tconv_task(F, F.in(I_F1D) + (size_t)l * DFF * 1024, nullptr, 1024, 2816, F.w<bf16_t>(WS_WD1), (u / 11) * 64, (u % 11) * 256, 0, nullptr, nullptr, nullptr, nullptr); }
        else if (t < e2) { const int u = t - e1; tconv_task(F, F.in(I_WIN) + (size_t)l * 1024 * NIN, nullptr, NIN, 1024, F.w<bf16_t>(WS_WIN), (u >> 2) * 64, (u & 3) * 256, 2, nullptr, nullptr, nullptr, nullptr); }
        else if (t < e3) { int u = t - e2; const int br = u / nt3; u -= br * nt3;
            const float* sp = (br == 0 ? F.in(I_WBA) : (br == 1 ? F.in(I_WBS) : F.in(I_WBH))) + (size_t)l * 512 * 1024;
            tconv_task(F, sp, nullptr, 1024, 512, F.w<bf16_t>(WS_WBR) + (size_t)br * 1024 * 512, (u >> 1) * 64, (u & 1) * 256, 0, nullptr, nullptr, nullptr, nullptr); }
        else if (t < e4) { const int u = t - e3; tconv_task(F, F.in(I_WOUT) + (size_t)l * 1024 * 1024, nullptr, 1024, 1024, F.w<bf16_t>(WS_WOUT), (u >> 2) * 64, (u & 3) * 256, 0, nullptr, nullptr, nullptr, nullptr); }
        else if (t < e5) { const int u = t - e4; tconv_task(F, F.in(I_F2G) + (size_t)l * 1024 * DFF, F.in(I_F2U) + (size_t)l * 1024 * DFF, DFF, 1024, F.w<bf16_t>(WS_WGU2), (u >> 2) * 64, (u & 3) * 256, 1, nullptr, nullptr, nullptr, nullptr); }
        else { const int u = t - e5; tconv_task(F, F.in(I_F2D) + (size_t)l * DFF * 1024, nullptr, 1024, 2816, F.w<bf16_t>(WS_WD2), (u / 11) * 64, (u % 11) * 256, 0, nullptr, nullptr, nullptr, nullptr); }
    }
    __syncthreads();
}
__device__ __forceinline__ void phase_convert(const Frame& F) {
    const int l = F.l;
    convert_tasks(F, 0, CT_SPLIT, F.bid, F.G);
    float* bp = F.w<float>(WS_BIAS);
    { const int n = F.bid * NTHR + F.tid; if (n < NH) { const int c = win_map(n); bp[n] = c >= 0 ? F.in(I_BIN)[(size_t)l * NIN + c] : 0.f; } }
    if (l == 0) {
        float* X = F.w<float>(WS_X); bf16_t* XB = F.w<bf16_t>(WS_XB);
        const size_t n4 = (size_t)MP * 256;
        for (size_t i = (size_t)F.bid * NTHR + F.tid; i < n4; i += (size_t)F.G * NTHR) {
            const size_t row = i >> 8; f32x4 v = (f32x4){0.f, 0.f, 0.f, 0.f};
            if (row < TP) v = __builtin_nontemporal_load((const f32x4*)F.in(I_XP) + i); else if (row < MR) v = ((const f32x4*)F.in(I_XS))[i - (size_t)TP * 256];
            if (row >= TP) ((f32x4*)X)[i] = v * ALPHA; u32x2 w; w.x = cvt_pk_bf16(v[0], v[1]); w.y = cvt_pk_bf16(v[2], v[3]); ((u32x2*)XB)[i] = w; }
    }
}

__device__ __forceinline__ void phase_ln(const Frame& F, const float* g, const float* b, float* final_out) {
    float* X = F.w<float>(WS_X); bf16_t* XB = F.w<bf16_t>(WS_XB);
    for (int row0 = (F.bid * 8 + F.wave) * 2; row0 < MP; row0 += F.G * 16) {
        f32x4 v[2][4]; float s[2] = {0.f, 0.f};
#pragma unroll
        for (int r = 0; r < 2; ++r)
#pragma unroll
            for (int j = 0; j < 4; ++j) v[r][j] = __builtin_nontemporal_load((const f32x4*)(X + (size_t)(row0 + r) * DM + j * 256 + F.lane * 4));
#pragma unroll
        for (int r = 0; r < 2; ++r)
#pragma unroll
            for (int j = 0; j < 4; ++j) s[r] += v[r][j][0] + v[r][j][1] + v[r][j][2] + v[r][j][3];
        const float mu0 = wave_sum(s[0]) * (1.0f / DM), mu1 = wave_sum(s[1]) * (1.0f / DM); float q[2] = {0.f, 0.f};
#pragma unroll
        for (int r = 0; r < 2; ++r)
#pragma unroll
            for (int j = 0; j < 4; ++j) { v[r][j] -= (r ? mu1 : mu0); q[r] += v[r][j][0] * v[r][j][0] + v[r][j][1] * v[r][j][1] + v[r][j][2] * v[r][j][2] + v[r][j][3] * v[r][j][3]; }
        const float rs0 = rsqrtf(wave_sum(q[0]) * (1.0f / DM) + 1e-5f), rs1 = rsqrtf(wave_sum(q[1]) * (1.0f / DM) + 1e-5f);
#pragma unroll
        for (int j = 0; j < 4; ++j) { const int c = j * 256 + F.lane * 4; const f32x4 gv = *(const f32x4*)(g + c), bv = *(const f32x4*)(b + c);
#pragma unroll
            for (int r = 0; r < 2; ++r) { const size_t row = (size_t)(row0 + r); const f32x4 o = v[r][j] * (r ? rs1 : rs0) * gv + bv;
                if (row >= TP) *(f32x4*)(X + row * DM + c) = o * ALPHA;
                u32x2 w; w.x = cvt_pk_bf16(o[0], o[1]); w.y = cvt_pk_bf16(o[2], o[3]); *(u32x2*)(XB + row * DM + c) = w;
                if (final_out && row < MR) __builtin_nontemporal_store(o, (f32x4*)(final_out + row * DM + c)); } }
    }
}

__device__ __forceinline__ void item_attn(const Frame& F, int item) {
    const int l = F.l, qb = item & 63, kvh = (item >> 6) & 1, b = item >> 7, q0 = qb * 64, kp0 = q0 - 128;
    const bf16_t* HB = F.w<bf16_t>(WS_HB); bf16_t* YA = F.w<bf16_t>(WS_YA);
    constexpr int KP = 72, VP = 216, PP = 168;
    bf16_t* Ks = (bf16_t*)F.sm;
    bf16_t* Vt = Ks + 192 * KP;
    bf16_t* Pw = Vt + 64 * VP + F.wave * 16 * PP;
    const size_t rowb = (size_t)b * SEQ;
    __syncthreads();
    for (int e = F.tid; e < 208 * 8; e += NTHR) { const int j = e >> 3, d8 = (e & 7) * 8, pos = kp0 + j;
        u32x4 kw = (u32x4){0u, 0u, 0u, 0u}, vw = kw;
        if (j < 192 && pos >= 0) { const bf16_t* hr = HB + (rowb + pos) * NH; kw = *(const u32x4*)(hr + HC_K + kvh * 64 + d8); vw = *(const u32x4*)(hr + HC_V + kvh * 64 + d8); }
        if (j < 192) *(u32x4*)(Ks + j * KP + d8) = kw;
        const unsigned vv[4] = {vw.x, vw.y, vw.z, vw.w};
#pragma unroll
        for (int i = 0; i < 4; ++i) { Vt[(d8 + 2 * i) * VP + j] = (bf16_t)(vv[i] & 0xFFFFu); Vt[(d8 + 2 * i + 1) * VP + j] = (bf16_t)(vv[i] >> 16); }
        if (qb >= 62 && j >= 128 && j < 192) {
            float kf[8], vf[8]; unpack8(kw, kf); unpack8(vw, vf);
            float* pk = F.p->out + O_PK + ((((size_t)l * NB + b) * 128 + (pos - (SEQ - 128))) * 2 + kvh) * 64 + d8;
            float* pv = F.p->out + O_PV + ((((size_t)l * NB + b) * 128 + (pos - (SEQ - 128))) * 2 + kvh) * 64 + d8;
#pragma unroll
            for (int i = 0; i < 8; ++i) { pk[i] = kf[i]; pv[i] = vf[i]; } }
    }
    __syncthreads();
    const int hh = F.wave >> 1, qh = F.wave & 1, h = kvh * 4 + hh, lane = F.lane, c = lane & 15, quad = lane >> 4;
    const float slope = exp2f(-(float)(h + 1)), sink = F.in(I_SINK)[l * 8 + h];
    for (int mt = 0; mt < 2; ++mt) {
        const int base = qh * 32 + mt * 16;
        const bf16_t* qp = HB + (rowb + q0 + base + c) * NH + HC_Q + h * 64 + quad * 8;
        const bf16x8 a0 = *(const bf16x8*)qp, a1 = *(const bf16x8*)(qp + 32);
        f32x4 s[9];
#pragma unroll
        for (int nt = 0; nt < 9; ++nt) { const bf16_t* kp = Ks + (base + nt * 16 + c) * KP + quad * 8;
            f32x4 acc = (f32x4){0.f, 0.f, 0.f, 0.f};
            acc = __builtin_amdgcn_mfma_f32_16x16x32_bf16(a0, *(const bf16x8*)kp, acc, 0, 0, 0);
            acc = __builtin_amdgcn_mfma_f32_16x16x32_bf16(a1, *(const bf16x8*)(kp + 32), acc, 0, 0, 0);
            s[nt] = acc; }
        float mx[4] = {-1e30f, -1e30f, -1e30f, -1e30f};
#pragma unroll
        for (int nt = 0; nt < 9; ++nt) { const int kpos = kp0 + base + nt * 16 + c;
#pragma unroll
            for (int j = 0; j < 4; ++j) { const int r = quad * 4 + j, dist = 128 + r - nt * 16 - c;
                const bool ok = (dist >= 0) && (dist <= 128) && (kpos >= 0);
                const float v = ok ? s[nt][j] * 0.125f - slope * (float)dist : -1e30f; s[nt][j] = v; mx[j] = fmaxf(mx[j], v); } }
        float den[4];
#pragma unroll
        for (int j = 0; j < 4; ++j) { mx[j] = fmaxf(quad16_max(mx[j]), sink); den[j] = 0.f; }
#pragma unroll
        for (int nt = 0; nt < 9; ++nt)
#pragma unroll
            for (int j = 0; j < 4; ++j) { const float pz = __expf(s[nt][j] - mx[j]); den[j] += pz; Pw[(quad * 4 + j) * PP + nt * 16 + c] = f2bf(pz); }
#pragma unroll
        for (int j = 0; j < 4; ++j) { den[j] = __builtin_amdgcn_rcpf(quad16_sum(den[j]) + __expf(sink - mx[j])); Pw[(quad * 4 + j) * PP + 144 + c] = 0; }
        f32x4 o[4];
#pragma unroll
        for (int nt = 0; nt < 4; ++nt) o[nt] = mma16(Pw, PP, Vt + (nt * 16) * VP + base, VP, 160, (f32x4){0.f, 0.f, 0.f, 0.f}, lane);
#pragma unroll
        for (int nt = 0; nt < 4; ++nt)
#pragma unroll
            for (int j = 0; j < 4; ++j) YA[(rowb + q0 + base + quad * 4 + j) * 512 + h * 64 + nt * 16 + c] = f2bf(o[nt][j] * den[j]);
    }
}

__device__ __forceinline__ void item_attn_dec(const Frame& F, int b) {
    const int l = F.l; const size_t sr = (size_t)TP + b;
    const bf16_t* HB = F.w<bf16_t>(WS_HB); bf16_t* YA = F.w<bf16_t>(WS_YA);
    constexpr int KVP = 129;
    float* KV = (float*)F.sm;
    float* Qs = KV + 129 * KVP;
    float* Ps = Qs + 512;
    const float* ck = F.in(I_CK) + ((size_t)l * MS + b) * 128 * 128; const float* cv = F.in(I_CV) + ((size_t)l * MS + b) * 128 * 128;
    float* ok = F.p->out + O_SK + ((size_t)l * MS + b) * 128 * 128; float* ov = F.p->out + O_SV + ((size_t)l * MS + b) * 128 * 128;
    __syncthreads();
    for (int e0 = F.tid; e0 < 128 * 128; e0 += NTHR * 8) { float v[8];
#pragma unroll
        for (int i = 0; i < 8; ++i) v[i] = __builtin_nontemporal_load(ck + e0 + i * NTHR);
#pragma unroll
        for (int i = 0; i < 8; ++i) { const int e = e0 + i * NTHR, j = e >> 7, cc = e & 127; KV[j * KVP + cc] = v[i]; if (j >= 1) __builtin_nontemporal_store(v[i], ok + e - 128); } }
    if (F.tid < 128) { const float v = bf2f(HB[sr * NH + HC_K + F.tid]); KV[128 * KVP + F.tid] = v; ok[127 * 128 + F.tid] = v; }
    Qs[F.tid] = bf2f(HB[sr * NH + HC_Q + F.tid]);
    { float* mg = F.w<float>(WS_MERGED) + sr * DM; mg[F.tid] = 0.f; mg[512 + F.tid] = 0.f; }
    __syncthreads();
    for (int idx = F.tid; idx < 8 * 129; idx += NTHR) { const int h = idx / 129, j = idx - h * 129, kvh = h >> 2;
        float s = 0.f;
#pragma unroll 8
        for (int d = 0; d < 64; ++d) s += Qs[h * 64 + d] * KV[j * KVP + kvh * 64 + d];
        Ps[h * 132 + j] = s * 0.125f - exp2f(-(float)(h + 1)) * (float)(128 - j); }
    __syncthreads();
    { const int h = F.wave; const float sink = F.in(I_SINK)[l * 8 + h];
      const float s0 = Ps[h * 132 + F.lane], s1 = Ps[h * 132 + 64 + F.lane], s2 = (F.lane == 0) ? Ps[h * 132 + 128] : -1e30f;
      const float m = fmaxf(wave_max(fmaxf(fmaxf(s0, s1), s2)), sink);
      const float p0 = __expf(s0 - m), p1 = __expf(s1 - m), p2 = (F.lane == 0) ? __expf(s2 - m) : 0.f;
      const float den = wave_sum(p0 + p1 + p2) + __expf(sink - m), inv = 1.0f / den;
      Ps[h * 132 + F.lane] = p0 * inv; Ps[h * 132 + 64 + F.lane] = p1 * inv; if (F.lane == 0) Ps[h * 132 + 128] = p2 * inv; }
    __syncthreads();
    for (int e0 = F.tid; e0 < 128 * 128; e0 += NTHR * 8) { float v[8];
#pragma unroll
        for (int i = 0; i < 8; ++i) v[i] = __builtin_nontemporal_load(cv + e0 + i * NTHR);
#pragma unroll
        for (int i = 0; i < 8; ++i) { const int e = e0 + i * NTHR, j = e >> 7, cc = e & 127; KV[j * KVP + cc] = v[i]; if (j >= 1) __builtin_nontemporal_store(v[i], ov + e - 128); } }
    if (F.tid < 128) { const float v = bf2f(HB[sr * NH + HC_V + F.tid]); KV[128 * KVP + F.tid] = v; ov[127 * 128 + F.tid] = v; }
    __syncthreads();
    { const int h = F.tid >> 6, d = F.tid & 63, kvh = h >> 2; float o = 0.f;
      for (int j = 0; j < 129; ++j) o += Ps[h * 132 + j] * KV[j * KVP + kvh * 64 + d];
      YA[sr * 512 + F.tid] = f2bf(o); }
}

__device__ __forceinline__ void item_ssd_a(const Frame& F, int item) {
    const int l = F.l, g = item & 1, c = (item >> 1) & 63, b = item >> 7, t0 = c * 64;
    const size_t r0 = (size_t)b * SEQ + t0;
    const bf16_t* HB = F.w<bf16_t>(WS_HB); bf16_t* ACT = F.w<bf16_t>(WS_ACT);
    constexpr int P = 72;
    bf16_t* Bn = (bf16_t*)F.sm;
    bf16_t* Cn = Bn + 64 * P;
    bf16_t* xT = Cn + 64 * P;
    bf16_t* Wp = xT + 4 * 64 * P + F.wave * 32 * P;
    float* a_s = (float*)(xT + 4 * 64 * P + 8 * 32 * P);
    float* dt_s = a_s + 256;
    __syncthreads();
    if (F.wave < 4) { const int h = g * 4 + F.wave, t = F.lane;
        const float dt = softplusf_(bf2f(HB[(r0 + t) * NH + HC_DT + h]) + F.in(I_DTB)[l * 8 + h]);
        const float A = -__expf(F.in(I_ALOG)[l * 8 + h]);
        const float a = wave_incl_scan(dt * A, t);
        a_s[t * 4 + F.wave] = a; dt_s[t * 4 + F.wave] = dt;
        F.w<float>(WS_ACUM)[(r0 + t) * 8 + h] = a;
        if (t == 63) F.w<float>(WS_DECS)[((size_t)b * 64 + c) * 8 + h] = __expf(a); }
    const float* cw = F.in(I_CONVW) + (size_t)l * 4 * 768; const float* cb = F.in(I_CONVB) + (size_t)l * 768;
    for (int e = F.tid; e < 48 * 64; e += NTHR) { const int t = e & 63, cg8 = e >> 6;
        const int ch = cg8 < 32 ? g * 256 + cg8 * 8 : (cg8 < 40 ? 512 + g * 64 + (cg8 - 32) * 8 : 640 + g * 64 + (cg8 - 40) * 8);
        float acc[8];
#pragma unroll
        for (int i = 0; i < 8; ++i) acc[i] = cb[ch + i];
#pragma unroll
        for (int w = 0; w < 4; ++w) { const int tt = t0 + t - 3 + w;
            if (tt >= 0) { float xv[8]; unpack8(*(const u32x4*)(HB + ((size_t)b * SEQ + tt) * NH + HC_XBC + ch), xv);
                const f32x4 w0 = *(const f32x4*)(cw + w * 768 + ch), w1 = *(const f32x4*)(cw + w * 768 + ch + 4);
#pragma unroll
                for (int i = 0; i < 4; ++i) { acc[i] += xv[i] * w0[i]; acc[4 + i] += xv[4 + i] * w1[i]; } } }
        bf16_t ob[8];
#pragma unroll
        for (int i = 0; i < 8; ++i) ob[i] = f2bf(siluf_(acc[i]));
        u32x4 w; w.x = ob[0] | ((unsigned)ob[1] << 16); w.y = ob[2] | ((unsigned)ob[3] << 16); w.z = ob[4] | ((unsigned)ob[5] << 16); w.w = ob[6] | ((unsigned)ob[7] << 16);
        *(u32x4*)(ACT + (r0 + t) * 768 + ch) = w;
        if (cg8 < 32) { const int hh = cg8 >> 3, p0 = (cg8 & 7) * 8;
#pragma unroll
            for (int i = 0; i < 8; ++i) xT[(hh * 64 + p0 + i) * P + t] = ob[i]; }
        else if (cg8 < 40) *(u32x4*)(Bn + t * P + (cg8 - 32) * 8) = w;
        else *(u32x4*)(Cn + t * P + (cg8 - 40) * 8) = w;
        if (c == 63 && t >= 61) {
            float xv[8]; unpack8(*(const u32x4*)(HB + (r0 + t) * NH + HC_XBC + ch), xv);
            float* pc = F.p->out + O_PC + (((size_t)l * NB + b) * 3 + (t - 61)) * 768 + ch;
#pragma unroll
            for (int i = 0; i < 8; ++i) pc[i] = xv[i]; }
    }
    __syncthreads();
    const int hh = F.wave >> 1, th = F.wave & 1, h = g * 4 + hh, lane = F.lane, cc = lane & 15, quad = lane >> 4;
#pragma unroll
    for (int mt = 0; mt < 2; ++mt)
#pragma unroll
        for (int nt = 0; nt < 4; ++nt) {
            f32x4 gt = (f32x4){0.f, 0.f, 0.f, 0.f};
            if (nt <= th * 2 + mt) gt = mma16(Cn + (th * 32 + mt * 16) * P, P, Bn + (nt * 16) * P, P, 64, gt, lane);
            const int s = nt * 16 + cc; const float as = a_s[s * 4 + hh], dts = dt_s[s * 4 + hh];
#pragma unroll
            for (int j = 0; j < 4; ++j) { const int t = th * 32 + mt * 16 + quad * 4 + j;
                const float w = (s <= t) ? gt[j] * __expf(a_s[t * 4 + hh] - as) * dts : 0.f;
                Wp[(mt * 16 + quad * 4 + j) * P + s] = f2bf(w); } }
    bf16_t* Y = F.w<bf16_t>(WS_YSSD);
#pragma unroll
    for (int mt = 0; mt < 2; ++mt)
#pragma unroll
        for (int nt = 0; nt < 4; ++nt) {
            const f32x4 y = mma16(xT + (hh * 64 + nt * 16) * P, P, Wp + (mt * 16) * P, P, 64, (f32x4){0.f, 0.f, 0.f, 0.f}, lane);
            u32x2 w; w.x = pk_bf16_c(y[0], y[1]); w.y = pk_bf16_c(y[2], y[3]); *(u32x2*)(Y + (r0 + th * 32 + mt * 16 + cc) * 512 + h * 64 + nt * 16 + quad * 4) = w; }
    { const float al = a_s[63 * 4 + hh];
      for (int e = lane; e < 32 * 64; e += 64) { const int s = e & 63, nl = e >> 6;
          Wp[nl * P + s] = f2bf(bf2f(Bn[s * P + th * 32 + nl]) * __expf(al - a_s[s * 4 + hh]) * dt_s[s * 4 + hh]); } }
    bf16_t* CS = F.w<bf16_t>(WS_CS) + (((size_t)b * 64 + c) * 8 + h) * 4096;
#pragma unroll
    for (int mt = 0; mt < 4; ++mt)
#pragma unroll
        for (int nt = 0; nt < 2; ++nt) {
            const f32x4 v = mma16(Wp + (nt * 16) * P, P, xT + (hh * 64 + mt * 16) * P, P, 64, (f32x4){0.f, 0.f, 0.f, 0.f}, lane);
            u32x2 w; w.x = pk_bf16_c(v[0], v[1]); w.y = pk_bf16_c(v[2], v[3]); *(u32x2*)(CS + (mt * 16 + cc) * 64 + th * 32 + nt * 16 + quad * 4) = w; }
}

__device__ __forceinline__ void item_ssd_dec(const Frame& F, int b) {
    const int l = F.l; const size_t sr = (size_t)TP + b;
    const bf16_t* HB = F.w<bf16_t>(WS_HB);
    float* act = (float*)F.sm;
    float* ys = act + 768;
    float* red = ys + 512;
    __syncthreads();
    const float* cw = F.in(I_CONVW) + (size_t)l * 4 * 768; const float* cb = F.in(I_CONVB) + (size_t)l * 768;
    const float* sc = F.in(I_SCONV) + ((size_t)l * MS + b) * 3 * 768; float* oc = F.p->out + O_SC + ((size_t)l * MS + b) * 3 * 768;
    for (int ch = F.tid; ch < 768; ch += NTHR) { const float o0 = sc[ch], o1 = sc[768 + ch], o2 = sc[1536 + ch], nw = bf2f(HB[sr * NH + HC_XBC + ch]);
        act[ch] = siluf_(o0 * cw[ch] + o1 * cw[768 + ch] + o2 * cw[1536 + ch] + nw * cw[2304 + ch] + cb[ch]);
        oc[ch] = o1; oc[768 + ch] = o2; oc[1536 + ch] = nw; }
    __syncthreads();
    { const int h = F.wave, g = h >> 2, n = F.lane;
      const float dt = softplusf_(bf2f(HB[sr * NH + HC_DT + h]) + F.in(I_DTB)[l * 8 + h]);
      const float dA = __expf(dt * -__expf(F.in(I_ALOG)[l * 8 + h]));
      const float Bv = act[512 + g * 64 + n] * dt, Cv = act[640 + g * 64 + n], Dh = F.in(I_DSKIP)[l * 8 + h];
      const float* s0 = F.in(I_SSSM) + (((size_t)l * MS + b) * 8 + h) * 4096; float* s1 = F.p->out + O_SSSM + (((size_t)l * MS + b) * 8 + h) * 4096;
#pragma unroll 16
      for (int p = 0; p < 64; ++p) { const float x = act[h * 64 + p]; const float hT = dA * __builtin_nontemporal_load(s0 + p * 64 + n) + x * Bv; __builtin_nontemporal_store(hT, s1 + p * 64 + n);
          const float y = wave_sum(Cv * hT);
          if (n == 0) ys[h * 64 + p] = (y + Dh * x) * siluf_(bf2f(HB[sr * NH + HC_Z + h * 64 + p])); } }
    __syncthreads();
    { const float y = ys[F.tid]; const float q = wave_sum(y * y); if (F.lane == 0) red[F.wave] = q; __syncthreads();
      float tot = 0.f;
#pragma unroll
      for (int i = 0; i < 8; ++i) tot += red[i];
      F.w<bf16_t>(WS_YM)[sr * 512 + F.tid] = f2bf(y * rsqrtf(tot * (1.0f / 512.f) + 1e-6f) * F.in(I_SNW)[l * 512 + F.tid]); }
}

__device__ __forceinline__ void item_ssd_c(const Frame& F, int item) {
    const int l = F.l, c = item & 63, b = item >> 6; const size_t r0 = (size_t)b * SEQ + c * 64;
    const bf16_t* HB = F.w<bf16_t>(WS_HB); const bf16_t* ACT = F.w<bf16_t>(WS_ACT);
    constexpr int P = 72;
    bf16_t* Cn = (bf16_t*)F.sm;
    bf16_t* Hn = Cn + 2 * 64 * P + F.wave * 64 * P;
    float* ssq = (float*)(Cn + 2 * 64 * P + 8 * 64 * P);
    const int h = F.wave, g = h >> 2, lane = F.lane, cc = lane & 15, quad = lane >> 4;
    __syncthreads();
    for (int e = F.tid; e < 2 * 64 * 8; e += NTHR) { const int n8 = (e & 7) * 8, t = (e >> 3) & 63, gg = e >> 9;
        *(u32x4*)(Cn + (gg * 64 + t) * P + n8) = *(const u32x4*)(ACT + (r0 + t) * 768 + 640 + gg * 64 + n8); }
    { const bf16_t* hs = F.w<bf16_t>(WS_CS) + (((size_t)b * 64 + c) * 8 + h) * 4096;
      for (int e = lane; e < 64 * 8; e += 64) { const int p = e >> 3, n8 = (e & 7) * 8; *(u32x4*)(Hn + p * P + n8) = *(const u32x4*)(hs + p * 64 + n8); } }
    __syncthreads();
    const float Dh = F.in(I_DSKIP)[l * 8 + h];
    const bf16_t* Y = F.w<bf16_t>(WS_YSSD); const float* AC = F.w<float>(WS_ACUM);
    f32x4 y[4][4];
#pragma unroll
    for (int mt = 0; mt < 4; ++mt) { const size_t row = r0 + mt * 16 + cc;
        const float ea = __expf(AC[row * 8 + h]); float q = 0.f;
#pragma unroll
        for (int nt = 0; nt < 4; ++nt) { const f32x4 v = mma16(Hn + (nt * 16) * P, P, Cn + (g * 64 + mt * 16) * P, P, 64, (f32x4){0.f, 0.f, 0.f, 0.f}, lane);
            const int col = h * 64 + nt * 16 + quad * 4;
            const u32x2 yw = *(const u32x2*)(Y + row * 512 + col); const float yi[4] = {__uint_as_float(yw.x << 16), __uint_as_float(yw.x & 0xFFFF0000u), __uint_as_float(yw.y << 16), __uint_as_float(yw.y & 0xFFFF0000u)};
            const u32x2 xw = *(const u32x2*)(ACT + row * 768 + col), zw = *(const u32x2*)(HB + row * NH + HC_Z + col);
            const float xv[4] = {__uint_as_float(xw.x << 16), __uint_as_float(xw.x & 0xFFFF0000u), __uint_as_float(xw.y << 16), __uint_as_float(xw.y & 0xFFFF0000u)};
            const float zv[4] = {__uint_as_float(zw.x << 16), __uint_as_float(zw.x & 0xFFFF0000u), __uint_as_float(zw.y << 16), __uint_as_float(zw.y & 0xFFFF0000u)};
#pragma unroll
            for (int j = 0; j < 4; ++j) { float yy = (yi[j] + ea * v[j] + Dh * xv[j]) * siluf_(zv[j]); y[mt][nt][j] = yy; q += yy * yy; } }
        q += __shfl_xor(q, 16); q += __shfl_xor(q, 32);
        if (quad == 0) ssq[h * 64 + mt * 16 + cc] = q; }
    __syncthreads();
    bf16_t* YM = F.w<bf16_t>(WS_YM); const float* nw = F.in(I_SNW) + l * 512;
#pragma unroll
    for (int mt = 0; mt < 4; ++mt) { const int t = mt * 16 + cc; float tot = 0.f;
#pragma unroll
        for (int i = 0; i < 8; ++i) tot += ssq[i * 64 + t];
        const float rstd = rsqrtf(tot * (1.0f / 512.f) + 1e-6f);
#pragma unroll
        for (int nt = 0; nt < 4; ++nt) { const int col = h * 64 + nt * 16 + quad * 4; const f32x4 w4 = *(const f32x4*)(nw + col);
            u32x2 w; w.x = cvt_pk_bf16(y[mt][nt][0] * rstd * w4[0], y[mt][nt][1] * rstd * w4[1]); w.y = cvt_pk_bf16(y[mt][nt][2] * rstd * w4[2], y[mt][nt][3] * rstd * w4[3]);
            *(u32x2*)(YM + (r0 + t) * 512 + col) = w; } }
}

__device__ __forceinline__ void item_hg_a(const Frame& F, int item) {
    const int l = F.l, c = item & 63, hd = (item >> 6) & 3, b = item >> 8; const size_t r0 = (size_t)b * SEQ + c * 64;
    const bf16_t* HB = F.w<bf16_t>(WS_HB);
    constexpr int QP = 130, BP = 129, P = 72;
    bf16_t* q_s = (bf16_t*)F.sm;
    bf16_t* k_s = q_s + 64 * QP;
    float* bc = (float*)(k_s + 64 * QP);
    bf16_t* att = (bf16_t*)(bc + 64 * BP);
    bf16_t* iT = att + 64 * P;
    bf16_t* keT = iT + 128 * P;
    const int lane = F.lane, cc = lane & 15, quad = lane >> 4;
    float* lbs = (float*)(keT + 128 * P);
    __syncthreads();
    if (F.tid < 128) lbs[F.tid] = lb_of(F.in(I_LBL), l, hd * 128 + F.tid);
    __syncthreads();
    for (int e = F.tid; e < 64 * 16; e += NTHR) { const int t = e >> 4, k8 = (e & 15) * 8; const bf16_t* hr = HB + (r0 + t) * NH + hd * 128 + k8;
        float qv[8], fv[8]; unpack8(*(const u32x4*)(hr + HC_HQ), qv); unpack8(*(const u32x4*)(hr + HC_HF), fv);
        const u32x4 iw = *(const u32x4*)(hr + HC_HI); const unsigned iv[4] = {iw.x, iw.y, iw.z, iw.w};
#pragma unroll
        for (int i = 0; i < 8; ++i) { const float lbv = lbs[k8 + i];
            const float sg = __builtin_amdgcn_rcpf(1.0f + __expf(-fv[i])), sgn = __builtin_amdgcn_rcpf(1.0f + __expf(fv[i]));
            q_s[t * QP + k8 + i] = f2bf(siluf_(qv[i])); k_s[t * QP + k8 + i] = f2bf((1.0f - lbv) * sgn);
            bc[t * BP + k8 + i] = __logf(lbv + (1.0f - lbv) * sg); }
#pragma unroll
        for (int i = 0; i < 4; ++i) { iT[(k8 + 2 * i) * P + t] = (bf16_t)(iv[i] & 0xFFFFu); iT[(k8 + 2 * i + 1) * P + t] = (bf16_t)(iv[i] >> 16); } }
    __syncthreads();
    for (int k = F.wave; k < 128; k += 8) bc[lane * BP + k] = wave_incl_scan(bc[lane * BP + k], lane);
    __syncthreads();
    constexpr int DP = 136;
    bf16_t* qd = (bf16_t*)(lbs + 128);
    bf16_t* kd = keT;
    for (int e = F.tid; e < 64 * 128; e += NTHR) { const int r = e >> 7, k = e & 127;
        const int ref = r < 32 ? 31 : (r < 48 ? 15 : 47), t = r < 32 ? 32 + r : (r < 48 ? r - 16 : r), sx = r < 32 ? r : (r < 48 ? r - 32 : r - 16);
        const float br = bc[ref * BP + k];
        qd[r * DP + k] = f2bf(bf2f(q_s[t * QP + k]) * __expf(bc[t * BP + k] - br));
        kd[r * DP + k] = f2bf(bf2f(k_s[sx * QP + k]) * __expf(br - bc[sx * BP + k])); }
    { const int idx = F.tid, B = idx / 136, p = idx - B * 136;
      int i = (int)((sqrtf(8.0f * (float)p + 1.0f) - 1.0f) * 0.5f); while ((i + 1) * (i + 2) / 2 <= p) ++i; while (i * (i + 1) / 2 > p) --i;
      const int j = p - i * (i + 1) / 2, t = 16 * B + i, sx = 16 * B + j; float a = 0.f;
#pragma unroll 4
      for (int k = 0; k < 128; ++k) a += bf2f(q_s[t * QP + k]) * bf2f(k_s[sx * QP + k]) * __expf(bc[t * BP + k] - bc[sx * BP + k]);
      att[t * P + sx] = f2bf(a); }
    { const int p = 512 + (F.tid >> 4) - 3 * 136, ks = (F.tid & 15) * 8;
      int i = (int)((sqrtf(8.0f * (float)p + 1.0f) - 1.0f) * 0.5f); while ((i + 1) * (i + 2) / 2 <= p) ++i; while (i * (i + 1) / 2 > p) --i;
      const int j = p - i * (i + 1) / 2, t = 48 + i, sx = 48 + j; float a = 0.f;
#pragma unroll
      for (int k = ks; k < ks + 8; ++k) a += bf2f(q_s[t * QP + k]) * bf2f(k_s[sx * QP + k]) * __expf(bc[t * BP + k] - bc[sx * BP + k]);
      a = quad16_sum(a); if ((F.tid & 15) == 0) att[t * P + sx] = f2bf(a); }
    for (int e = F.tid; e < 64 * 64; e += NTHR) { const int t = e >> 6, sx = e & 63; if (sx > t) att[t * P + sx] = 0; }
    __syncthreads();
    if (F.wave < 6) { const int w = F.wave; const int qr = w < 4 ? (w >> 1) * 16 : (w == 4 ? 32 : 48), kr = w < 4 ? (w & 1) * 16 : (w == 4 ? 32 : 48);
        const int t0 = w < 4 ? 32 + (w >> 1) * 16 : (w == 4 ? 16 : 48), s0 = w < 4 ? (w & 1) * 16 : (w == 4 ? 0 : 32);
        const f32x4 v = mma16(qd + qr * DP, DP, kd + kr * DP, DP, 128, (f32x4){0.f, 0.f, 0.f, 0.f}, lane);
#pragma unroll
        for (int j = 0; j < 4; ++j) att[(t0 + quad * 4 + j) * P + s0 + cc] = f2bf(v[j]); }
    __syncthreads();
    bf16_t* QE = F.w<bf16_t>(WS_QE);
    for (int e = F.tid; e < 64 * 128; e += NTHR) { const int s = e >> 7, k = e & 127; const float bb = bc[s * BP + k];
        keT[k * P + s] = f2bf(bf2f(k_s[s * QP + k]) * __expf(bc[63 * BP + k] - bb));
        QE[(r0 + s) * 512 + hd * 128 + k] = f2bf(bf2f(q_s[s * QP + k]) * __expf(bb)); }
    if (F.tid < 128) F.w<float>(WS_DECH)[(((size_t)b * 4 + hd) * 64 + c) * 128 + F.tid] = __expf(bc[63 * BP + F.tid]);
    __syncthreads();
    bf16_t* OH = F.w<bf16_t>(WS_OHG);
    { const int mt = F.wave >> 1;
#pragma unroll
      for (int n4 = 0; n4 < 4; ++n4) { const int nt = (F.wave & 1) * 4 + n4;
          const f32x4 v = mma16(iT + (nt * 16) * P, P, att + (mt * 16) * P, P, 64, (f32x4){0.f, 0.f, 0.f, 0.f}, lane);
          u32x2 w; w.x = pk_bf16_c(v[0], v[1]); w.y = pk_bf16_c(v[2], v[3]); *(u32x2*)(OH + (r0 + mt * 16 + cc) * 512 + hd * 128 + nt * 16 + quad * 4) = w; } }
    bf16_t* KC = F.w<bf16_t>(WS_KC) + (((size_t)b * 4 + hd) * 64 + c) * 16384;
#pragma unroll
    for (int nt = 0; nt < 8; ++nt) { const f32x4 v = mma16(keT + (F.wave * 16) * P, P, iT + (nt * 16) * P, P, 64, (f32x4){0.f, 0.f, 0.f, 0.f}, lane);
        { u32x2 w; w.x = pk_bf16_c(v[0], v[1]); w.y = pk_bf16_c(v[2], v[3]); *(u32x2*)(KC + (nt * 16 + cc) * 128 + F.wave * 16 + quad * 4) = w; } }
}

__device__ __forceinline__ void item_hg_c(const Frame& F, int item) {
    const int l = F.l, c = item & 63, hd = (item >> 6) & 3, b = item >> 8; const size_t r0 = (size_t)b * SEQ + c * 64;
    const bf16_t* HB = F.w<bf16_t>(WS_HB);
    constexpr int P = 136;
    bf16_t* qe = (bf16_t*)F.sm;
    bf16_t* ST = qe + 64 * P;
    float* ssq = (float*)(ST + 128 * P);
    const int lane = F.lane, cc = lane & 15, quad = lane >> 4;
    __syncthreads();
    const bf16_t* QE = F.w<bf16_t>(WS_QE);
    for (int e = F.tid; e < 64 * 16; e += NTHR) { const int t = e >> 4, k8 = (e & 15) * 8; *(u32x4*)(qe + t * P + k8) = *(const u32x4*)(QE + (r0 + t) * 512 + hd * 128 + k8); }
    const bf16_t* Sp = F.w<bf16_t>(WS_KC) + (((size_t)b * 4 + hd) * 64 + c) * 16384;
    for (int e = F.tid; e < 128 * 16; e += NTHR) { const int v = e >> 4, k8 = (e & 15) * 8; *(u32x4*)(ST + v * P + k8) = *(const u32x4*)(Sp + v * 128 + k8); }
    __syncthreads();
    const int mt = F.wave >> 1, nh = F.wave & 1;
    const bf16_t* OH = F.w<bf16_t>(WS_OHG); const size_t row = r0 + mt * 16 + cc;
    f32x4 o[4]; float q = 0.f;
#pragma unroll
    for (int n4 = 0; n4 < 4; ++n4) { const int nt = nh * 4 + n4;
        o[n4] = mma16(ST + (nt * 16) * P, P, qe + (mt * 16) * P, P, 128, (f32x4){0.f, 0.f, 0.f, 0.f}, lane);
        { const u32x2 ow = *(const u32x2*)(OH + row * 512 + hd * 128 + nt * 16 + quad * 4); o[n4][0] += __uint_as_float(ow.x << 16); o[n4][1] += __uint_as_float(ow.x & 0xFFFF0000u); o[n4][2] += __uint_as_float(ow.y << 16); o[n4][3] += __uint_as_float(ow.y & 0xFFFF0000u); }
        q += o[n4][0] * o[n4][0] + o[n4][1] * o[n4][1] + o[n4][2] * o[n4][2] + o[n4][3] * o[n4][3]; }
    q += __shfl_xor(q, 16); q += __shfl_xor(q, 32);
    if (quad == 0) ssq[nh * 64 + mt * 16 + cc] = q;
    __syncthreads();
    bf16_t* YH = F.w<bf16_t>(WS_YH); const float* nw = F.in(I_HNW) + l * 128;
    { const int t = mt * 16 + cc; const float rstd = rsqrtf((ssq[t] + ssq[64 + t]) * (1.0f / 128.f) + 1e-6f);
#pragma unroll
      for (int n4 = 0; n4 < 4; ++n4) { const int v0 = (nh * 4 + n4) * 16 + quad * 4; const f32x4 w4 = *(const f32x4*)(nw + v0);
          const u32x2 gw = *(const u32x2*)(HB + row * NH + HC_HG + hd * 128 + v0);
          const float g0 = siluf_(__uint_as_float(gw.x << 16)), g1 = siluf_(__uint_as_float(gw.x & 0xFFFF0000u)), g2 = siluf_(__uint_as_float(gw.y << 16)), g3 = siluf_(__uint_as_float(gw.y & 0xFFFF0000u));
          u32x2 w; w.x = cvt_pk_bf16(o[n4][0] * rstd * w4[0] * g0, o[n4][1] * rstd * w4[1] * g1); w.y = cvt_pk_bf16(o[n4][2] * rstd * w4[2] * g2, o[n4][3] * rstd * w4[3] * g3);
          *(u32x2*)(YH + row * 512 + hd * 128 + v0) = w; } }
}

__device__ __forceinline__ void item_hg_dec(const Frame& F, int item) {
    const int l = F.l, hd = item & 3, b = item >> 2; const size_t sr = (size_t)TP + b;
    const bf16_t* HB = F.w<bf16_t>(WS_HB);
    float* fq = (float*)F.sm;
    float* op = fq + 384;
    float* red = op + 512;
    __syncthreads();
    if (F.tid < 128) { const int k = F.tid; const float lbv = lb_of(F.in(I_LBL), l, hd * 128 + k); const float fl = bf2f(HB[sr * NH + HC_HF + hd * 128 + k]);
        fq[k] = lbv + (1.0f - lbv) / (1.0f + __expf(-fl)); fq[128 + k] = (1.0f - lbv) / (1.0f + __expf(fl)); fq[256 + k] = siluf_(bf2f(HB[sr * NH + HC_HQ + hd * 128 + k])); }
    __syncthreads();
    const int kq = F.tid >> 7, v = F.tid & 127; const float iv = bf2f(HB[sr * NH + HC_HI + hd * 128 + v]);
    const float* s0 = F.in(I_SHG) + (((size_t)l * MS + b) * 4 + hd) * 16384; float* s1 = F.p->out + O_SHG + (((size_t)l * MS + b) * 4 + hd) * 16384;
    float o = 0.f;
#pragma unroll 16
    for (int k = kq * 32; k < kq * 32 + 32; ++k) { const float sn = fq[k] * __builtin_nontemporal_load(s0 + k * 128 + v) + fq[128 + k] * iv; __builtin_nontemporal_store(sn, s1 + k * 128 + v); o += fq[256 + k] * sn; }
    op[kq * 128 + v] = o;
    __syncthreads();
    if (F.tid < 128) { const float ov = op[v] + op[128 + v] + op[256 + v] + op[384 + v]; const float q = wave_sum(ov * ov); if (F.lane == 0) red[F.wave] = q; op[v] = ov; }
    __syncthreads();
    if (F.tid < 128) { const float rstd = rsqrtf((red[0] + red[1]) * (1.0f / 128.f) + 1e-6f);
        F.w<bf16_t>(WS_YH)[sr * 512 + hd * 128 + v] = f2bf(op[v] * rstd * F.in(I_HNW)[l * 128 + v] * siluf_(bf2f(HB[sr * NH + HC_HG + hd * 128 + v]))); }
}

__device__ __forceinline__ void phase_scan(const Frame& F) {
    const int l = F.l;
    if (F.tid < 256) { unsigned* CS = F.w<unsigned>(WS_CS); const float* DE = F.w<float>(WS_DECS);
      for (int e = F.bid * 256 + F.tid; e < 4 * 8 * 2048; e += F.G * 256) { const int b = e >> 14, h = (e >> 11) & 7, pn2 = e & 2047; float S0 = 0.f, S1 = 0.f;
          unsigned* base = CS + ((size_t)b * 64 * 8 + h) * 2048 + pn2; const float* db = DE + (size_t)b * 64 * 8 + h;
          for (int c0 = 0; c0 < 64; c0 += 16) { unsigned v[16]; float d[16];
#pragma unroll
              for (int i = 0; i < 16; ++i) { v[i] = base[(size_t)(c0 + i) * 8 * 2048]; d[i] = db[(c0 + i) * 8]; }
#pragma unroll
              for (int i = 0; i < 16; ++i) { base[(size_t)(c0 + i) * 8 * 2048] = cvt_pk_bf16(S0, S1); S0 = d[i] * S0 + __uint_as_float(v[i] << 16); S1 = d[i] * S1 + __uint_as_float(v[i] & 0xFFFF0000u); } }
          *(float2*)(F.p->out + O_PSSM + (((size_t)l * NB + b) * 8 + h) * 4096 + pn2 * 2) = make_float2(S0, S1); } }
    { unsigned* KC = F.w<unsigned>(WS_KC); const float* DE = F.w<float>(WS_DECH); const int gt = F.bid * NTHR + F.tid, gn = F.G * NTHR;
      for (int e = gt; e < 4 * 4 * 8192; e += gn) { const int bh = e >> 13, kv = (e & 8191) * 2, k = kv & 127, vv = kv >> 7; float S0 = 0.f, S1 = 0.f;
          unsigned* base = KC + (size_t)bh * 64 * 8192 + (kv >> 1); const float* db = DE + (size_t)bh * 64 * 128 + k;
          for (int c0 = 0; c0 < 64; c0 += 16) { unsigned v[16]; float2 d[16];
#pragma unroll
              for (int i = 0; i < 16; ++i) { v[i] = base[(size_t)(c0 + i) * 8192]; d[i] = *(const float2*)(db + (c0 + i) * 128); }
#pragma unroll
              for (int i = 0; i < 16; ++i) { base[(size_t)(c0 + i) * 8192] = cvt_pk_bf16(S0, S1); S0 = d[i].x * S0 + __uint_as_float(v[i] << 16); S1 = d[i].y * S1 + __uint_as_float(v[i] & 0xFFFF0000u); } }
          float* po = F.p->out + O_PHG + ((size_t)l * 16 + bh) * 16384; po[k * 128 + vv] = S0; po[(k + 1) * 128 + vv] = S1; } }
}

template <bool A_F32, int MODE>
__device__ __forceinline__ void skinny_unit(const Frame& F, const void* A, int lda, const bf16_t* Bt, int ldb, int kbeg, int klen, int n0, float* out, float scale, const bf16_t* gate) {
    const int m0 = F.wave * 16, r = F.lane & 15, q = F.lane >> 4;
    f32x4 acc = (f32x4){0.f, 0.f, 0.f, 0.f};
    const bf16_t* bp = Bt + (size_t)(n0 + r) * ldb + kbeg + q * 8;
    if (!A_F32) { const bf16_t* ap = (const bf16_t*)A + (size_t)(m0 + r) * lda + kbeg + q * 8;
#pragma unroll 8
        for (int k = 0; k < klen; k += 32) acc = __builtin_amdgcn_mfma_f32_16x16x32_bf16(*(const bf16x8*)(ap + k), *(const bf16x8*)(bp + k), acc, 0, 0, 0); }
    else { const float* ap = (const float*)A + (size_t)(m0 + r) * lda + kbeg + q * 8;
#pragma unroll 4
        for (int k = 0; k < klen; k += 32) { const f32x4 x0 = *(const f32x4*)(ap + k), x1 = *(const f32x4*)(ap + k + 4);
            u32x4 w; w.x = cvt_pk_bf16(x0[0], x0[1]); w.y = cvt_pk_bf16(x0[2], x0[3]); w.z = cvt_pk_bf16(x1[0], x1[1]); w.w = cvt_pk_bf16(x1[2], x1[3]);
            bf16x8 a; __builtin_memcpy(&a, &w, 16);
            acc = __builtin_amdgcn_mfma_f32_16x16x32_bf16(a, *(const bf16x8*)(bp + k), acc, 0, 0, 0); } }
#pragma unroll
    for (int j = 0; j < 4; ++j) { const int row = m0 + q * 4 + j, col = n0 + r;
        float v = acc[j] * scale;
        if (MODE == 1) v = acc[j] * sigmoidf_(bf2f(gate[(size_t)row * NH + col]));
        atomicAdd(out + (size_t)row * DM + col, v); }
}

__global__ void __launch_bounds__(NTHR, 2) fwd_megakernel(Params prm) {
    extern __shared__ __attribute__((aligned(16))) unsigned char lds[];
    cg::grid_group grid = cg::this_grid();
    Frame F; F.p = &prm; F.ws = prm.ws; F.sm = lds; F.tid = threadIdx.x; F.lane = F.tid & 63; F.wave = __builtin_amdgcn_readfirstlane(F.tid >> 6); F.G = gridDim.x; F.bid = blockIdx.x; F.l = 0;
    PG8_LAS unsigned char* glds = (PG8_LAS unsigned char*)lds;
    if (threadIdx.x < 4) ((volatile LAS unsigned*)(glds + LDS_GEMM))[threadIdx.x] = 0u;
    __syncthreads();
    XcdBarrier xbar = xcd_barrier_post((unsigned*)(prm.ws + WS_BAR), (volatile LAS unsigned*)(glds + LDS_GEMM));
#define REFRESH() do { int t_ = threadIdx.x; asm volatile("" : "+v"(t_)); F.tid = t_; F.lane = t_ & 63; F.wave = __builtin_amdgcn_readfirstlane(t_ >> 6); } while (0)
    for (int l = 0; l < 4; ++l) {
        F.l = l;
        if (l == 0) { REFRESH(); phase_convert(F); grid.sync(); }
        for (int f = 0; f < 2; ++f) {
            if (f == 1) {
                { pg8::Gemm g{F.w<bf16_t>(WS_XB), F.w<bf16_t>(WS_WIN), MP, NH, 1024, 0, 0}; pg8::StaticOrder S; S.init(MP, NH, F.G, F.bid);
                  EpiBiasBf16 E{F.w<bf16_t>(WS_HB), F.w<float>(WS_BIAS)}; REFRESH();
                  { const int nb = (MP / 256) * (NH / 256) % F.G; if (nb && F.bid >= nb) convert_tasks(F, CT_E2, CT_E5, F.bid - nb, F.G - nb); }
                  REFRESH(); pg8::gemm_phase(glds, g, S, E, F.tid); }
                xcd_barrier(xbar);
                for (int it = F.bid; it < 2816; it += F.G) { REFRESH();
                    if (it < 512) item_attn(F, it); else if (it < 1024) item_ssd_a(F, it - 512); else if (it < 2048) item_hg_a(F, it - 1024);
                    else if (it < 2176) item_attn_dec(F, it - 2048); else if (it < 2304) item_ssd_dec(F, it - 2176); else item_hg_dec(F, it - 2304); }
                xcd_barrier(xbar);
                REFRESH(); phase_scan(F);
                xcd_barrier(xbar);
                for (int it = F.bid; it < 1280; it += F.G) { REFRESH(); if (it < 256) item_ssd_c(F, it); else item_hg_c(F, it - 256); }
                __syncthreads();
                xcd_barrier(xbar);
                { pg8::TripleOrder S; S.init(TP, 1024, F.G, F.bid);
                  pg8::Gemm g{F.w<bf16_t>(WS_YA), F.w<bf16_t>(WS_WBR), TP, 1024, 512, (size_t)MP * 512 * 2, (size_t)1024 * 512 * 2};
                  EpiMergeZ E{F.w<bf16_t>(WS_MB), F.w<bf16_t>(WS_HB)}; REFRESH(); pg8::gemm_phase(glds, g, S, E, F.tid); }
                REFRESH();
                for (int u = F.bid; u < 192; u += F.G) { const int br = u >> 6, nt = u & 63;
                    const bf16_t* ya = (br == 0 ? F.w<bf16_t>(WS_YA) : (br == 1 ? F.w<bf16_t>(WS_YM) : F.w<bf16_t>(WS_YH))) + (size_t)TP * 512;
                    skinny_unit<false, 1>(F, ya, 512, F.w<bf16_t>(WS_WBR) + (size_t)br * 1024 * 512, 512, 0, 512, nt * 16, F.w<float>(WS_MERGED) + (size_t)TP * DM, 1.f, F.w<bf16_t>(WS_HB) + (size_t)TP * NH + HC_GATE + br * 1024); }
                xcd_barrier(xbar);
                { pg8::Gemm g{F.w<bf16_t>(WS_MB), F.w<bf16_t>(WS_WOUT), TP, 1024, 1024, 0, 0}; pg8::StaticOrder S; S.init(TP, 1024, F.G, F.bid);
                  EpiResid E{F.w<float>(WS_X), F.w<bf16_t>(WS_XB), 1.0f}; REFRESH(); pg8::gemm_phase(glds, g, S, E, F.tid); }
                REFRESH();
                for (int u = F.bid; u < 256; u += F.G)
                    skinny_unit<true, 0>(F, F.w<float>(WS_MERGED) + (size_t)TP * DM, 1024, F.w<bf16_t>(WS_WOUT), 1024, (u >> 6) * 256, 256, (u & 63) * 16, F.w<float>(WS_X) + (size_t)TP * DM, 1.f, nullptr);
                xcd_barrier(xbar);
                REFRESH(); phase_ln(F, F.in(I_LN2G) + l * 1024, F.in(I_LN2B) + l * 1024, nullptr);
                xcd_barrier(xbar);
            }
            { pg8::Gemm g{F.w<bf16_t>(WS_XB), F.w<bf16_t>(f ? WS_WGU2 : WS_WGU1), MP, 5632, 1024, 0, 0}; pg8::StaticOrder S; S.init(MP, 5632, F.G, F.bid);
              EpiSwiglu E{F.w<bf16_t>(WS_HB)}; REFRESH();
              { const int nb = (MP / 256) * (5632 / 256) % F.G; if (nb && F.bid >= nb) { if (f == 0) convert_tasks(F, CT_SPLIT, CT_E2, F.bid - nb, F.G - nb); else convert_tasks(F, CT_E5, CT_E6, F.bid - nb, F.G - nb); } }
              REFRESH(); pg8::gemm_phase(glds, g, S, E, F.tid); }
            xcd_barrier(xbar);
            { pg8::Gemm g{F.w<bf16_t>(WS_HB), F.w<bf16_t>(f ? WS_WD2 : WS_WD1), TP, 1024, 2816, 0, 0}; pg8::StaticOrder S; S.init(TP, 1024, F.G, F.bid);
              EpiResid E{F.w<float>(WS_X), F.w<bf16_t>(WS_XB), 0.5f}; REFRESH(); pg8::gemm_phase(glds, g, S, E, F.tid); }
            REFRESH();
            for (int u = F.bid; u < 256; u += F.G)
                skinny_unit<false, 0>(F, F.w<bf16_t>(WS_HB) + (size_t)TP * DFF, DFF, F.w<bf16_t>(f ? WS_WD2 : WS_WD1), DFF, (u >> 6) * 704, 704, (u & 63) * 16, F.w<float>(WS_X) + (size_t)TP * DM, 0.5f, nullptr);
            xcd_barrier(xbar);
            REFRESH(); phase_ln(F, F.in(f ? I_LN3G : I_LN1G) + l * 1024, F.in(f ? I_LN3B : I_LN1B) + l * 1024, (f == 1 && l == 3) ? prm.out : nullptr);
            if (f == 1 && l < 3) { F.l = l + 1; REFRESH(); phase_convert(F); F.l = l; }
            xcd_barrier(xbar);
        }
    }
}

extern "C" void kernel_launch(void* const* d_in, const int* in_sizes, int n_in, void* d_out, int out_size, void* d_ws, size_t ws_size, hipStream_t stream) {
    static int grid = 0;
    if (grid == 0) {
        if (n_in != 34 || (size_t)out_size != O_END || ws_size < WS_END) { fprintf(stderr, "kernel_launch: unexpected shapes n_in %d out %d ws %zu (need %zu)\n", n_in, out_size, ws_size, (size_t)WS_END); grid = -1; return; }
        int dev = 0, cus = 0, per_cu = 0;
        hipGetDevice(&dev); hipDeviceGetAttribute(&cus, hipDeviceAttributeMultiprocessorCount, dev);
        if (hipFuncSetAttribute((const void*)fwd_megakernel, hipFuncAttributeMaxDynamicSharedMemorySize, LDS_BYTES) != hipSuccess) { fprintf(stderr, "kernel_launch: hipFuncSetAttribute failed\n"); grid = -1; return; }
        if (hipOccupancyMaxActiveBlocksPerMultiprocessor(&per_cu, (const void*)fwd_megakernel, NTHR, LDS_BYTES) != hipSuccess || per_cu < 1) { fprintf(stderr, "kernel_launch: occupancy query failed (%d)\n", per_cu); per_cu = 1; (void)hipGetLastError(); }
        if (per_cu > 1) per_cu = 1;
        grid = cus * per_cu;
        if ((long)grid * NTHR < MP) { fprintf(stderr, "kernel_launch: grid too small\n"); grid = -1; return; }
    }
    if (grid < 0) return;
    Params p{};
    for (int i = 0; i < 34; ++i) p.in[i] = (const float*)d_in[i];
    p.out = (float*)d_out; p.ws = (unsigned char*)d_ws;
    if (hipMemsetAsync((char*)d_ws + WS_BAR, 0, (size_t)XCD_BAR_WORDS * 4, stream) != hipSuccess) { fprintf(stderr, "memset failed\n"); return; }
    void* args[] = {&p};
    hipError_t e = hipLaunchCooperativeKernel((const void*)fwd_megakernel, dim3(grid), dim3(NTHR), args, LDS_BYTES, stream);
    if (e != hipSuccess) fprintf(stderr, "cooperative launch failed: %s (grid %d)\n", hipGetErrorString(e), grid);
}
```

```cpp
#include <hip/hip_runtime.h>
#include <hip/hip_cooperative_groups.h>
#include <cstdio>
namespace cg = cooperative_groups;

namespace pg8 {
#define PG8_LAS __attribute__((address_space(3)))
typedef unsigned short bf16_t;
typedef short bf16x8 __attribute__((ext_vector_type(8)));
typedef float f32x4 __attribute__((ext_vector_type(4)));
typedef unsigned u32x4 __attribute__((ext_vector_type(4)));
typedef unsigned u32x2 __attribute__((ext_vector_type(2)));
constexpr int BM = 256, BK = 64, HALF = 128, HTB = HALF * BK * 2, STAGE_BYTES = 8 * HTB, NXCD = 8, WGM = 8;

__host__ __device__ __forceinline__ int lds_byte(int r, int c) { const int st = (r >> 4) * 2 + (c >> 5), rr = r & 15, cc = c & 31, ob = rr * 64 + cc * 2; return st * 1024 + (ob ^ (((ob >> 9) & 1) << 5)); }
__host__ __device__ __forceinline__ void stage_rc(int b, int& R, int& C) { const int st = b / 1024, sb = b % 1024, swz = sb ^ (((sb >> 9) & 1) << 5); R = (st >> 1) * 16 + swz / 64; C = (st & 1) * 32 + (swz % 64) / 2; }
__host__ __device__ __forceinline__ int perm32(int rho) { const int n = rho >> 4, i = rho & 15; return 8 * (i >> 2) + 4 * n + (i & 3); }

struct Unit { int pm, pn; };
struct Gemm { const bf16_t* A; const bf16_t* Bt; int M, N, K; };

struct StaticOrder {
    int nM, nN, nwg, G, c;
    __device__ void init(int M, int N, int G_, int c_) { nM = M / BM; nN = N / BM; nwg = nM * nN; G = G_; c = c_; }
    __device__ bool next(int i, Unit& u) const {
        const long L = (long)i * G + c; if (L >= nwg) return false;
        int wgid = (int)L; { const int q = nwg / NXCD, r = nwg % NXCD, xcd = wgid % NXCD, off = wgid / NXCD; wgid = (xcd < r ? xcd * (q + 1) : r * (q + 1) + (xcd - r) * q) + off; }
        const int nig = WGM * nN, gid = wgid / nig, fm = gid * WGM, gsz = (nM - fm) < WGM ? (nM - fm) : WGM;
        u.pm = fm + ((wgid % nig) % gsz); u.pn = (wgid % nig) / gsz; return true;
    }
};

__device__ __forceinline__ unsigned cvt_pk_bf16(float lo, float hi) { unsigned r; asm volatile("v_cvt_pk_bf16_f32 %0, %1, %2" : "=v"(r) : "v"(lo), "v"(hi)); return r; }

template <class Epi>
__device__ __forceinline__ void gemm_phase(PG8_LAS unsigned char* lds, const Gemm g, const StaticOrder& S, const Epi& E, const int tid) {
    const int wid = __builtin_amdgcn_readfirstlane(tid >> 6), lane = tid & 63, wr = wid >> 2, wc = wid & 3, fr = lane & 15, fq = lane >> 4;
    const int K = g.K, nt = K / BK;
    unsigned voffA[2], voffB[2];
#pragma unroll
    for (int i = 0; i < 2; ++i) { int R, C; stage_rc(tid * 16 + i * 8192, R, C); const int Rb = Epi::PERM ? ((R & ~31) + perm32(R & 31)) : R;
        voffA[i] = (unsigned)(R * K + C) * 2u; voffB[i] = (unsigned)(Rb * K + C) * 2u; }
    const size_t kstep = (size_t)(BK * 2);
    const size_t hstep = (size_t)HALF * K * 2;
    const size_t tstep = 2 * hstep;
    const unsigned ldsw = (unsigned)wid * 1024u;
    const int aoff = lds_byte(wr * 64 + fr, fq * 8), boff = lds_byte(wc * 32 + fr, fq * 8);
#define PG8_SA(b, h) (((b) * 2 + (h)) * HTB)
#define PG8_SB(b, h) ((4 + (b) * 2 + (h)) * HTB)
#define PG8_STAGE(bufoff, gbase, voff) do { _Pragma("unroll") for (int _i = 0; _i < 2; ++_i) \
        __builtin_amdgcn_global_load_lds((const unsigned*)((const char*)(gbase) + (voff)[_i]), (PG8_LAS unsigned*)(lds + (bufoff) + ldsw + _i * 8192), 16, 0, 0); } while (0)
#define PG8_LDA(dst, b, h) do { _Pragma("unroll") for (int m = 0; m < 4; ++m) _Pragma("unroll") for (int k = 0; k < 2; ++k) dst[m][k] = *(const PG8_LAS bf16x8*)(lds + PG8_SA(b, h) + aoff + m * 2048 + k * 1024); } while (0)
#define PG8_LDB(dst, b, h) do { _Pragma("unroll") for (int n = 0; n < 2; ++n) _Pragma("unroll") for (int k = 0; k < 2; ++k) dst[n][k] = *(const PG8_LAS bf16x8*)(lds + PG8_SB(b, h) + boff + n * 2048 + k * 1024); } while (0)
#define PG8_MMA(ai, bj, At, Bt) do { __builtin_amdgcn_s_setprio(1); _Pragma("unroll") for (int m = 0; m < 4; ++m) _Pragma("unroll") for (int n = 0; n < 2; ++n) _Pragma("unroll") for (int k = 0; k < 2; ++k) \
        acc[ai][bj][m][n] = __builtin_amdgcn_mfma_f32_16x16x32_bf16(Bt[n][k], At[m][k], acc[ai][bj][m][n], 0, 0, 0); __builtin_amdgcn_s_setprio(0); } while (0)
#define PG8_WAIT_V(n) asm volatile("s_waitcnt vmcnt(" #n ")" ::: "memory")
#define PG8_WAIT_L(n) asm volatile("s_waitcnt lgkmcnt(" #n ")" ::: "memory")
#define PG8_BAR __builtin_amdgcn_s_barrier()
#define PG8_SCHED __builtin_amdgcn_sched_barrier(0)
    Unit cur, nxt; int ui = 0;
    if (!S.next(0, cur)) return;
    f32x4 acc[2][2][4][2];
#pragma unroll
    for (int a = 0; a < 2; ++a)
#pragma unroll
        for (int b = 0; b < 2; ++b)
#pragma unroll
            for (int m = 0; m < 4; ++m)
#pragma unroll
                for (int n = 0; n < 2; ++n) acc[a][b][m][n] = (f32x4){0.f, 0.f, 0.f, 0.f};
    bf16x8 At[4][2], B0[2][2], B1[2][2];
    const char* cA = (const char*)g.A + (size_t)cur.pm * tstep; const char* cB = (const char*)g.Bt + (size_t)cur.pn * tstep;
    PG8_STAGE(PG8_SB(0, 0), cB, voffB); PG8_STAGE(PG8_SA(0, 0), cA, voffA); PG8_STAGE(PG8_SB(0, 1), cB + hstep, voffB); PG8_STAGE(PG8_SA(0, 1), cA + hstep, voffA);
    if (wr == 1) PG8_BAR;
    PG8_WAIT_V(4); PG8_BAR;
    PG8_STAGE(PG8_SB(1, 0), cB + kstep, voffB); PG8_STAGE(PG8_SA(1, 0), cA + kstep, voffA); PG8_STAGE(PG8_SB(1, 1), cB + hstep + kstep, voffB);
    PG8_WAIT_V(6); PG8_BAR;
    for (;;) {
        const bool has_next = S.next(ui + 1, nxt);
        const char* nA = has_next ? (const char*)g.A + (size_t)nxt.pm * tstep : cA; const char* nB = has_next ? (const char*)g.Bt + (size_t)nxt.pn * tstep : cB;
        for (int t = 0; t < nt; t += 2) {
            const bool last = (t == nt - 2);
            const char* a1 = cA + (size_t)(t + 1) * kstep;
            const char* a2 = last ? nA : cA + (size_t)(t + 2) * kstep; const char* b2 = last ? nB : cB + (size_t)(t + 2) * kstep;
            const char* a3 = a2 + kstep; const char* b3 = b2 + kstep;
            PG8_LDB(B0, 0, 0); PG8_SCHED; PG8_LDA(At, 0, 0); PG8_STAGE(PG8_SA(1, 1), a1 + hstep, voffA);
            PG8_WAIT_L(8); PG8_BAR; PG8_WAIT_L(0); PG8_MMA(0, 0, At, B0); PG8_BAR; PG8_SCHED;
            PG8_LDB(B1, 0, 1); PG8_STAGE(PG8_SB(0, 0), b2, voffB);
            PG8_BAR; PG8_WAIT_L(0); PG8_MMA(0, 1, At, B1); PG8_BAR;
            PG8_LDA(At, 0, 1); PG8_STAGE(PG8_SA(0, 0), a2, voffA);
            PG8_BAR; PG8_WAIT_L(0); PG8_MMA(1, 0, At, B0); PG8_BAR; PG8_SCHED;
            PG8_STAGE(PG8_SB(0, 1), b2 + hstep, voffB);
            PG8_WAIT_V(6); PG8_BAR; PG8_MMA(1, 1, At, B1); PG8_BAR;
            PG8_LDB(B0, 1, 0); PG8_SCHED; PG8_LDA(At, 1, 0); PG8_STAGE(PG8_SA(0, 1), a2 + hstep, voffA);
            PG8_WAIT_L(8); PG8_BAR; PG8_WAIT_L(0); PG8_MMA(0, 0, At, B0); PG8_BAR; PG8_SCHED;
            PG8_LDB(B1, 1, 1); PG8_STAGE(PG8_SB(1, 0), b3, voffB);
            PG8_BAR; PG8_WAIT_L(0); PG8_MMA(0, 1, At, B1); PG8_BAR;
            PG8_LDA(At, 1, 1); PG8_STAGE(PG8_SA(1, 0), a3, voffA);
            PG8_BAR; PG8_WAIT_L(0); PG8_MMA(1, 0, At, B0); PG8_BAR; PG8_SCHED;
            PG8_STAGE(PG8_SB(1, 1), b3 + hstep, voffB);
            PG8_WAIT_V(6); PG8_BAR; PG8_MMA(1, 1, At, B1); PG8_BAR;
        }
        E(acc, cur, wr, wc, fr, fq);
        if (!has_next) break;
#pragma unroll
        for (int a = 0; a < 2; ++a)
#pragma unroll
            for (int b = 0; b < 2; ++b)
#pragma unroll
                for (int m = 0; m < 4; ++m)
#pragma unroll
                    for (int n = 0; n < 2; ++n) acc[a][b][m][n] = (f32x4){0.f, 0.f, 0.f, 0.f};
        cur = nxt; cA = nA; cB = nB; ++ui;
    }
    PG8_WAIT_V(0);
    if (wr == 0) PG8_BAR;
    PG8_BAR;
#undef PG8_SA
#undef PG8_SB
#undef PG8_STAGE
#undef PG8_LDA
#undef PG8_LDB
#undef PG8_MMA
#undef PG8_WAIT_V
#undef PG8_WAIT_L
#undef PG8_BAR
#undef PG8_SCHED
}
}

using pg8::bf16_t; using pg8::bf16x8; using pg8::f32x4; using pg8::u32x4; using pg8::u32x2; using pg8::cvt_pk_bf16;

constexpr int DM = 1024, DFF = 2816, NIN = 7176, NH = 7424;
constexpr int TP = 16384, MS = 128, MR = TP + MS, MP = 16640, SEQ = 4096, NB = 4;
constexpr int NTHR = 512;
constexpr float ALPHA = 1.6817928305074290861f;
constexpr int LDS_GEMM = 131072;
constexpr int LDS_BYTES = 131072 + 16;
constexpr int HC_Q = 0, HC_K = 512, HC_V = 640, HC_Z = 768, HC_XBC = 1280, HC_HQ = 2048, HC_HF = 2560, HC_HI = 3072, HC_HG = 3584, HC_GATE = 4096, HC_DT = 7168;

constexpr size_t al256(size_t x) { return (x + 255) & ~(size_t)255; }
constexpr size_t WS_WGU1 = 0;
constexpr size_t WS_WD1 = WS_WGU1 + (size_t)5632 * 1024 * 2;
constexpr size_t WS_WIN = WS_WD1 + (size_t)1024 * 2816 * 2;
constexpr size_t WS_WBR = WS_WIN + (size_t)NH * 1024 * 2;
constexpr size_t WS_WOUT = WS_WBR + (size_t)3 * 1024 * 512 * 2;
constexpr size_t WS_WGU2 = WS_WOUT + (size_t)1024 * 1024 * 2;
constexpr size_t WS_WD2 = WS_WGU2 + (size_t)5632 * 1024 * 2;
constexpr size_t WS_BIAS = WS_WD2 + (size_t)1024 * 2816 * 2;
constexpr size_t WS_X = al256(WS_BIAS + (size_t)NH * 4);
constexpr size_t WS_XB = WS_X + (size_t)MP * 1024 * 4;
constexpr size_t WS_HB = WS_XB + (size_t)MP * 1024 * 2;
constexpr size_t WS_ACT = WS_HB + (size_t)MP * NH * 2;
constexpr size_t WS_ACUM = WS_ACT + (size_t)TP * 768 * 2;
constexpr size_t WS_MERGED = WS_ACUM + (size_t)TP * 8 * 4;
constexpr size_t WS_YSSD = WS_MERGED;
constexpr size_t WS_OHG = WS_MERGED + (size_t)TP * 512 * 4;
constexpr size_t WS_CS = WS_MERGED + (size_t)MP * 1024 * 4;
constexpr size_t WS_DECS = WS_CS + (size_t)4 * 64 * 8 * 4096 * 4;
constexpr size_t WS_KC = WS_DECS + (size_t)4 * 64 * 8 * 4;
constexpr size_t WS_DECH = WS_KC + (size_t)4 * 4 * 64 * 16384 * 4;
constexpr size_t WS_QE = WS_DECH + (size_t)4 * 4 * 64 * 128 * 4;
constexpr size_t WS_YA = WS_QE + (size_t)TP * 512 * 2;
constexpr size_t WS_YM = WS_YA + (size_t)MP * 512 * 2;
constexpr size_t WS_YH = WS_YM + (size_t)MP * 512 * 2;
constexpr size_t WS_MB = WS_YH + (size_t)MP * 512 * 2;
constexpr size_t WS_BAR = WS_MB + (size_t)MP * 1024 * 2;
constexpr size_t WS_END = WS_BAR + (size_t)3456 * 4;

constexpr size_t O_YP = 0, O_YS = 16777216, O_PK = 16908288, O_PV = 17170432, O_PC = 17432576, O_PSSM = 17469440, O_PHG = 17993728,
                 O_SK = 19042304, O_SV = 27430912, O_SC = 35819520, O_SSSM = 36999168, O_SHG = 53776384, O_END = 87330816;

struct Params { const float* in[34]; float* out; unsigned char* ws; };
enum { I_XP = 0, I_XS, I_CK, I_CV, I_SCONV, I_SSSM, I_SHG, I_LN1G, I_LN1B, I_F1G, I_F1U, I_F1D, I_WIN, I_BIN, I_SINK, I_CONVW, I_CONVB, I_DTB, I_ALOG, I_DSKIP,
       I_SNW, I_LBL, I_HNW, I_WBA, I_WBS, I_WBH, I_WOUT, I_LN2G, I_LN2B, I_F2G, I_F2U, I_F2D, I_LN3G, I_LN3B };

__device__ __forceinline__ float bf2f(bf16_t v) { return __uint_as_float(((unsigned)v) << 16); }
__device__ __forceinline__ bf16_t f2bf(float f) { unsigned u = __float_as_uint(f); u += 0x7FFFu + ((u >> 16) & 1u); return (bf16_t)(u >> 16); }
__device__ __forceinline__ unsigned pk_bf16_c(float lo, float hi) { return (unsigned)f2bf(lo) | ((unsigned)f2bf(hi) << 16); }
__device__ __forceinline__ float sigmoidf_(float x) { return __builtin_amdgcn_rcpf(1.0f + __expf(-x)); }
__device__ __forceinline__ float siluf_(float x) { return x * __builtin_amdgcn_rcpf(1.0f + __expf(-x)); }
__device__ __forceinline__ float siluf_fast(float x) { return x * __builtin_amdgcn_rcpf(1.0f + __expf(-x)); }
__device__ __forceinline__ float softplusf_(float x) { const float e = __expf(x); return x > 20.f ? x : (x < -8.f ? e * (1.0f - 0.5f * e) : __logf(1.0f + e)); }
__device__ __forceinline__ void unpack8(const u32x4 w, float* f) {
    f[0] = __uint_as_float(w.x << 16); f[1] = __uint_as_float(w.x & 0xFFFF0000u); f[2] = __uint_as_float(w.y << 16); f[3] = __uint_as_float(w.y & 0xFFFF0000u);
    f[4] = __uint_as_float(w.z << 16); f[5] = __uint_as_float(w.z & 0xFFFF0000u); f[6] = __uint_as_float(w.w << 16); f[7] = __uint_as_float(w.w & 0xFFFF0000u); }
__device__ __forceinline__ float quad16_sum(float v) { v += __shfl_xor(v, 1); v += __shfl_xor(v, 2); v += __shfl_xor(v, 4); v += __shfl_xor(v, 8); return v; }
__device__ __forceinline__ float quad16_max(float v) { v = fmaxf(v, __shfl_xor(v, 1)); v = fmaxf(v, __shfl_xor(v, 2)); v = fmaxf(v, __shfl_xor(v, 4)); v = fmaxf(v, __shfl_xor(v, 8)); return v; }
__device__ __forceinline__ float wave_sum(float v) { v += __shfl_xor(v, 1); v += __shfl_xor(v, 2); v += __shfl_xor(v, 4); v += __shfl_xor(v, 8); v += __shfl_xor(v, 16); v += __shfl_xor(v, 32); return v; }
__device__ __forceinline__ float wave_max(float v) { v = fmaxf(v, __shfl_xor(v, 1)); v = fmaxf(v, __shfl_xor(v, 2)); v = fmaxf(v, __shfl_xor(v, 4)); v = fmaxf(v, __shfl_xor(v, 8)); v = fmaxf(v, __shfl_xor(v, 16)); v = fmaxf(v, __shfl_xor(v, 32)); return v; }
__device__ __forceinline__ float wave_incl_scan(float v, int lane) {
#pragma unroll
    for (int d = 1; d < 64; d <<= 1) { float o = __shfl_up(v, d); if (lane >= d) v += o; }
    return v; }
__device__ __forceinline__ f32x4 mma16(const bf16_t* A, int lda, const bf16_t* Bt, int ldb, int K, f32x4 acc, int lane) {
    const int r = lane & 15, q = lane >> 4;
    const bf16_t* ap = A + r * lda + q * 8; const bf16_t* bp = Bt + r * ldb + q * 8;
    for (int k0 = 0; k0 < K; k0 += 32) { const bf16x8 a = *(const bf16x8*)(ap + k0); const bf16x8 b = *(const bf16x8*)(bp + k0); acc = __builtin_amdgcn_mfma_f32_16x16x32_bf16(a, b, acc, 0, 0, 0); }
    return acc; }
__device__ __forceinline__ float lb_of(const float* lbl, int l, int ch) {
    const float x0 = lbl[ch], x1 = lbl[512 + ch], x2 = lbl[1024 + ch], x3 = lbl[1536 + ch];
    const float m = fmaxf(fmaxf(x0, x1), fmaxf(x2, x3));
    const float e0 = __expf(x0 - m), e1 = __expf(x1 - m), e2 = __expf(x2 - m), e3 = __expf(x3 - m);
    const float s = e0 + e1 + e2 + e3;
    float acc = 0.f; if (l >= 1) acc += e1; if (l >= 2) acc += e2; if (l >= 3) acc += e3;
    return acc / s; }

struct EpiSwiglu {
    static constexpr bool PERM = true;
    bf16_t* H;
    __device__ __forceinline__ void operator()(const f32x4 (&acc)[2][2][4][2], const pg8::Unit& u, int wr, int wc, int fr, int fq) const {
        const int row0 = u.pm * 256 + wr * 64 + fr, col0 = u.pn * 128 + wc * 32 + 8 * fq;
#pragma unroll
        for (int ai = 0; ai < 2; ++ai)
#pragma unroll
            for (int m = 0; m < 4; ++m) {
                bf16_t* rowp = H + (size_t)(row0 + ai * 128 + m * 16) * DFF + col0;
                float h[8];
#pragma unroll
                for (int n = 0; n < 2; ++n)
#pragma unroll
                    for (int j = 0; j < 4; ++j) h[n * 4 + j] = siluf_fast(acc[ai][0][m][n][j]) * acc[ai][1][m][n][j];
                u32x4 w; w.x = cvt_pk_bf16(h[0], h[1]); w.y = cvt_pk_bf16(h[2], h[3]); w.z = cvt_pk_bf16(h[4], h[5]); w.w = cvt_pk_bf16(h[6], h[7]);
                *(u32x4*)rowp = w; __builtin_amdgcn_sched_barrier(0); }
    }
};
struct EpiResid {
    static constexpr bool PERM = true;
    float* X; const bf16_t* XB; float scale;
    __device__ __forceinline__ void operator()(const f32x4 (&acc)[2][2][4][2], const pg8::Unit& u, int wr, int wc, int fr, int fq) const {
        const int row0 = u.pm * 256 + wr * 64 + fr, col0 = u.pn * 256 + wc * 32 + 8 * fq;
#pragma unroll
        for (int ai = 0; ai < 2; ++ai)
#pragma unroll
            for (int m = 0; m < 4; ++m) { const size_t ro = (size_t)(row0 + ai * 128 + m * 16) * DM + col0;
#pragma unroll
                for (int bj = 0; bj < 2; ++bj) { float b[8]; unpack8(*(const u32x4*)(XB + ro + bj * 128), b);
                    const f32x4 x0 = (f32x4){b[0], b[1], b[2], b[3]}, x1 = (f32x4){b[4], b[5], b[6], b[7]};
                    *(f32x4*)(X + ro + bj * 128) = x0 * ALPHA + acc[ai][bj][m][0] * scale;
                    *(f32x4*)(X + ro + bj * 128 + 4) = x1 * ALPHA + acc[ai][bj][m][1] * scale; } }
    }
};
struct EpiBiasBf16 {
    static constexpr bool PERM = true;
    bf16_t* O; const float* bias;
    __device__ __forceinline__ void operator()(const f32x4 (&acc)[2][2][4][2], const pg8::Unit& u, int wr, int wc, int fr, int fq) const {
        const int row0 = u.pm * 256 + wr * 64 + fr, col0 = u.pn * 256 + wc * 32 + 8 * fq;
        f32x4 bv[2][2];
#pragma unroll
        for (int bj = 0; bj < 2; ++bj)
#pragma unroll
            for (int n = 0; n < 2; ++n) bv[bj][n] = *(const f32x4*)(bias + col0 + bj * 128 + 4 * n);
#pragma unroll
        for (int ai = 0; ai < 2; ++ai)
#pragma unroll
            for (int m = 0; m < 4; ++m) { bf16_t* rowp = O + (size_t)(row0 + ai * 128 + m * 16) * NH + col0;
#pragma unroll
                for (int bj = 0; bj < 2; ++bj) { const f32x4 v0 = acc[ai][bj][m][0] + bv[bj][0], v1 = acc[ai][bj][m][1] + bv[bj][1];
                    u32x4 w; w.x = cvt_pk_bf16(v0[0], v0[1]); w.y = cvt_pk_bf16(v0[2], v0[3]); w.z = cvt_pk_bf16(v1[0], v1[1]); w.w = cvt_pk_bf16(v1[2], v1[3]);
                    *(u32x4*)(rowp + bj * 128) = w; } }
    }
};
template <int MODE> struct EpiMerge {
    static constexpr bool PERM = true;
    float* MG; bf16_t* MB; const bf16_t* HBp; int gcol;
    __device__ __forceinline__ void operator()(const f32x4 (&acc)[2][2][4][2], const pg8::Unit& u, int wr, int wc, int fr, int fq) const {
        const int row0 = u.pm * 256 + wr * 64 + fr, col0 = u.pn * 256 + wc * 32 + 8 * fq;
#pragma unroll
        for (int ai = 0; ai < 2; ++ai)
#pragma unroll
            for (int m = 0; m < 4; ++m) { const size_t row = (size_t)(row0 + ai * 128 + m * 16);
#pragma unroll
                for (int bj = 0; bj < 2; ++bj) { const int c = col0 + bj * 128;
                    float gv[8]; unpack8(*(const u32x4*)(HBp + row * NH + gcol + c), gv);
                    float v[8];
#pragma unroll
                    for (int j = 0; j < 4; ++j) { v[j] = sigmoidf_(gv[j]) * acc[ai][bj][m][0][j]; v[4 + j] = sigmoidf_(gv[4 + j]) * acc[ai][bj][m][1][j]; }
                    u32x4* mp = (u32x4*)(MB + row * DM + c);
                    if (MODE >= 1) { float ov[8]; unpack8(*mp, ov);
#pragma unroll
                        for (int j = 0; j < 8; ++j) v[j] += ov[j]; }
                    u32x4 w; w.x = cvt_pk_bf16(v[0], v[1]); w.y = cvt_pk_bf16(v[2], v[3]); w.z = cvt_pk_bf16(v[4], v[5]); w.w = cvt_pk_bf16(v[6], v[7]); *mp = w; } }
    }
};

#define XB_TMO      128
#define XB_XCNT(j)  (256  + 64 * (j))
#define XB_XSUB(j)  (1280 + 64 * (j))
#define XB_XGEN(j)  (2304 + 64 * (j))
#define XB_TOP      3328
#define XB_TOPGEN   3392
#define XCD_BAR_WORDS 3456
#define XB_SPIN_CAP (1u << 18)
#define LAS __attribute__((address_space(3)))
__device__ __forceinline__ unsigned xb_ld(unsigned* p)              { return __hip_atomic_load(p, __ATOMIC_RELAXED, __HIP_MEMORY_SCOPE_AGENT); }
__device__ __forceinline__ unsigned xb_add(unsigned* p, unsigned v) { return __hip_atomic_fetch_add(p, v, __ATOMIC_RELAXED, __HIP_MEMORY_SCOPE_AGENT); }
__device__ __forceinline__ unsigned xb_xcc_id() { return (unsigned)__builtin_amdgcn_s_getreg((3 << 11) | 20) & 0xFu; }
#define XB_SPIN(cond, bar) do { unsigned _sp = 0; while (cond) { __builtin_amdgcn_s_sleep(1); \
    if ((++_sp & 255u) == 0u) { if (xb_ld(&(bar)[XB_TMO])) break; if (_sp > XB_SPIN_CAP) { atomicAdd(&(bar)[XB_TMO], 1u); break; } } } } while (0)
struct XcdBarrier { unsigned* bar; unsigned x; volatile LAS unsigned* st; };
__device__ __forceinline__ XcdBarrier xcd_barrier_post(unsigned* bar, volatile LAS unsigned* st) {
    XcdBarrier b; b.bar = bar; b.x = xb_xcc_id(); b.st = st;
    if (threadIdx.x == 0) (void)xb_add(&bar[XB_XCNT(b.x)], 1u);
    return b;
}
__device__ __forceinline__ void xcd_barrier_complete(unsigned* bar, unsigned x, unsigned& nloc, unsigned& nx) {
    const unsigned G = gridDim.x * gridDim.y * gridDim.z;
    unsigned sum, cnt, mine, sp = 0u;
    for (;;) {
        sum = 0u; cnt = 0u; mine = 0u;
#pragma unroll
        for (unsigned j = 0; j < 16; ++j) { const unsigned c = xb_ld(&bar[XB_XCNT(j)]); sum += c; cnt += (c > 0u) ? 1u : 0u; mine = (j == x) ? c : mine; }
        if (sum == G) break;
        __builtin_amdgcn_s_sleep(1);
        if ((++sp & 255u) == 0u) { if (xb_ld(&bar[XB_TMO])) break; if (sp > XB_SPIN_CAP) { atomicAdd(&bar[XB_TMO], 1u); break; } }
    }
    nloc = mine > 0u ? mine : 1u; nx = cnt > 0u ? cnt : 1u;
}
__device__ __forceinline__ void xcd_barrier(const XcdBarrier& b) {
    asm volatile("s_waitcnt vmcnt(0)" ::: "memory");
    __syncthreads();
    if (threadIdx.x == 0) {
        unsigned* bar = b.bar;
        __builtin_amdgcn_s_waitcnt(0);
        unsigned nloc = b.st[0], nx = b.st[1];
        if (nloc == 0u) { xcd_barrier_complete(bar, b.x, nloc, nx); b.st[0] = nloc; b.st[1] = nx; }
        const unsigned old = xb_add(&bar[XB_XSUB(b.x)], 1u);
        const unsigned gen = old / nloc;
        if (old + 1u == (gen + 1u) * nloc) {
            __builtin_amdgcn_fence(__ATOMIC_RELEASE, "agent");
            asm volatile("s_waitcnt vmcnt(0)" ::: "memory");
            const unsigned og = xb_add(&bar[XB_TOP], 1u);
            const unsigned tg = og / nx;
            if (og + 1u == (tg + 1u) * nx) xb_add(&bar[XB_TOPGEN], 1u);
            else XB_SPIN(xb_ld(&bar[XB_TOPGEN]) == tg, bar);
            __builtin_amdgcn_fence(__ATOMIC_ACQUIRE, "agent");
            xb_add(&bar[XB_XGEN(b.x)], 1u);
            asm volatile("s_waitcnt vmcnt(0)" ::: "memory");
        } else {
            XB_SPIN(xb_ld(&bar[XB_XGEN(b.x)]) == gen, bar);
            __builtin_amdgcn_fence(__ATOMIC_ACQUIRE, "agent");
            asm volatile("s_waitcnt vmcnt(0)" ::: "memory");
        }
    }
    __syncthreads();
}

struct Frame {
    const Params* p; unsigned char* ws; unsigned char* sm; int tid, lane, wave, G, bid, l;
    __device__ __forceinline__ const float* in(int i) const { return p->in[i]; }
    template <class T> __device__ __forceinline__ T* w(size_t off) const { return (T*)(ws + off); }
};

__device__ __forceinline__ int win_map(int n) { return n < 2048 ? n : (n < 4096 ? n + 8 : (n < 7168 ? n + 8 : (n < 7176 ? n - 7168 + 2048 : -1))); }
__device__ __forceinline__ void tconv_task(const Frame& F, const float* src, const float* src2, int Nsrc, int K, bf16_t* dst, int n0, int k0, int mode, const float* g, const float* b, float* cs, float* bw) {
    float* tile = (float*)F.sm;
    float* colsum = tile + 4 * 64 * 65;
    __syncthreads();
    if (F.tid < 128) colsum[F.tid] = 0.f;
    const int n4 = (F.tid & 15) * 4, n = n0 + n4;
    const float* sp = src; int col = n;
    if (mode == 1) { const int t = n >> 8, r = n & 255; sp = (r < 128) ? src : src2; col = t * 128 + (r & 127); }
    else if (mode == 2) col = win_map(n);
    f32x4 v[4][2];
#pragma unroll
    for (int j = 0; j < 4; ++j)
#pragma unroll
        for (int i = 0; i < 2; ++i) { const int kk = (F.tid >> 4) + i * 32;
            v[j][i] = (col >= 0) ? __builtin_nontemporal_load((const f32x4*)(sp + (size_t)(k0 + j * 64 + kk) * Nsrc + col)) : (f32x4){0.f, 0.f, 0.f, 0.f}; }
    __syncthreads();
    f32x4 csa = (f32x4){0.f, 0.f, 0.f, 0.f}, bwa = csa;
#pragma unroll
    for (int j = 0; j < 4; ++j)
#pragma unroll
        for (int i = 0; i < 2; ++i) { const int kk = (F.tid >> 4) + i * 32, k = k0 + j * 64 + kk; f32x4 w = v[j][i];
            if (cs) { const float gk = g ? g[k] : 1.f, bk = b ? b[k] : 0.f; bwa += w * bk; w *= gk;
#pragma unroll
                for (int c = 0; c < 4; ++c) { w[c] = bf2f(f2bf(w[c])); } csa += w; }
#pragma unroll
            for (int c = 0; c < 4; ++c) tile[(j * 64 + kk) * 65 + n4 + c] = w[c]; }
    if (cs) {
#pragma unroll
        for (int c = 0; c < 4; ++c) { float a = csa[c], bb = bwa[c]; a += __shfl_xor(a, 16); a += __shfl_xor(a, 32); bb += __shfl_xor(bb, 16); bb += __shfl_xor(bb, 32);
            if (F.lane < 16) { atomicAdd(&colsum[(n4 + c) * 2], a); atomicAdd(&colsum[(n4 + c) * 2 + 1], bb); } } }
    __syncthreads();
    for (int e = F.tid; e < 64 * 128; e += NTHR) { const int nn = e >> 7, kp = (e & 127) * 2;
        *(unsigned*)(dst + (size_t)(n0 + nn) * K + k0 + kp) = cvt_pk_bf16(tile[kp * 65 + nn], tile[(kp + 1) * 65 + nn]); }
    if (cs && F.tid < 64) { atomicAdd(cs + n0 + F.tid, colsum[F.tid * 2]); atomicAdd(bw + n0 + F.tid, colsum[F.tid * 2 + 1]); }
}
constexpr int CT_E0 = 352, CT_E1 = 528, CT_E2 = 992, CT_E3 = 1088, CT_E4 = 1152, CT_E5 = 1504, CT_E6 = 1680, CT_SPLIT = 674;
__device__ __forceinline__ void convert_tasks(const Frame& F, int lo, int hi, int start, int stride) {
    const int l = F.l;
    const int nt3 = (1024 / 64) * 2;
    const int e0 = CT_E0, e1 = CT_E1, e2 = CT_E2, e3 = CT_E3, e4 = CT_E4, e5 = CT_E5;
    for (int t = lo + start; t < hi; t += stride) {
        if (t < e0) tconv_task(F, F.in(I_F1G) + (size_t)l * 1024 * DFF, F.in(I_F1U) + (size_t)l * 1024 * DFF, DFF, 1024, F.w<bf16_t>(WS_WGU1), (t >> 2) * 64, (t & 3) * 256, 1, nullptr, nullptr, nullptr, nullptr);
        else if (t < e1) { const int u = t - e0; tconv_task(F, F.in(I_F1D) + (size_t)l * DFF * 1024, nullptr, 1024, 2816, F.w<bf16_t>(WS_WD1), (u / 11) * 64, (u % 11) * 256, 0, nullptr, nullptr, nullptr, nullptr); }
        else if (t < e2) { const int u = t - e1; tconv_task(F, F.in(I_WIN) + (size_t)l * 1024 * NIN, nullptr, NIN, 1024, F.w<bf16_t>(WS_WIN), (u >> 2) * 64, (u & 3) * 256, 2, nullptr, nullptr, nullptr, nullptr); }
        else if (t < e3) { int u = t - e2; const int br = u / nt3; u -= br * nt3;
            const float* sp = (br == 0 ? F.in(I_WBA) : (br == 1 ? F.in(I_WBS) : F.in(I_WBH))) + (size_t)l * 512 * 1024;
            tconv_task(F, sp, nullptr, 1024, 512, F.w<bf16_t>(WS_WBR) + (size_t)br * 1024 * 512, (u >> 1) * 64, (u & 1) * 256, 0, nullptr, nullptr, nullptr, nullptr); }
        else if (t < e4) { const int u = t - e3; tconv_task(F, F.in(I_WOUT) + (size_t)l * 1024 * 1024, nullptr, 1024, 1024, F.w<bf16_t>(WS_WOUT), (u >> 2) * 64, (u & 3) * 256, 0, nullptr, nullptr, nullptr, nullptr); }
        else if (t < e5) { const int u = t - e4; tconv_task(F, F.in(I_F2G) + (size_t)l * 1024 * DFF, F.in(I_F2U) + (size_t)l * 1024 * DFF, DFF, 1024, F.w<bf16_t>(WS_WGU2), (u >> 2) * 64, (u & 3) * 256, 1, nullptr, nullptr, nullptr, nullptr); }
        else { const int u = t - e5; tconv_task(F, F.in(I_F2D) + (size_t)l * DFF * 1024, nullptr, 1024, 2816, F.w<bf16_t>(WS_WD2), (u / 11) * 64, (u % 11) * 256, 0, nullptr, nullptr, nullptr, nullptr); }
    }
    __syncthreads();
}
__device__ __forceinline__ void phase_convert(const Frame& F) {
    const int l = F.l;
    convert_tasks(F, 0, CT_SPLIT, F.bid, F.G);
    float* bp = F.w<float>(WS_BIAS);
    { const int n = F.bid * NTHR + F.tid; if (n < NH) { const int c = win_map(n); bp[n] = c >= 0 ? F.in(I_BIN)[(size_t)l * NIN + c] : 0.f; } }
    if (l == 0) {
        float* X = F.w<float>(WS_X); bf16_t* XB = F.w<bf16_t>(WS_XB);
        const size_t n4 = (size_t)MP * 256;
        for (size_t i = (size_t)F.bid * NTHR + F.tid; i < n4; i += (size_t)F.G * NTHR) {
            const size_t row = i >> 8; f32x4 v = (f32x4){0.f, 0.f, 0.f, 0.f};
            if (row < TP) v = __builtin_nontemporal_load((const f32x4*)F.in(I_XP) + i); else if (row < MR) v = ((const f32x4*)F.in(I_XS))[i - (size_t)TP * 256];
            if (row >= TP) ((f32x4*)X)[i] = v * ALPHA; u32x2 w; w.x = cvt_pk_bf16(v[0], v[1]); w.y = cvt_pk_bf16(v[2], v[3]); ((u32x2*)XB)[i] = w; }
    }
}

__device__ __forceinline__ void phase_ln(const Frame& F, const float* g, const float* b, float* final_out) {
    float* X = F.w<float>(WS_X); bf16_t* XB = F.w<bf16_t>(WS_XB);
    constexpr int R = 4;
    for (int row0 = (F.bid * 8 + F.wave) * R; row0 < MP; row0 += F.G * 8 * R) {
        f32x4 v[R][4]; float s[R], q[R], mu[R], rs[R];
#pragma unroll
        for (int r = 0; r < R; ++r)
#pragma unroll
            for (int j = 0; j < 4; ++j) v[r][j] = __builtin_nontemporal_load((const f32x4*)(X + (size_t)(row0 + r) * DM + j * 256 + F.lane * 4));
#pragma unroll
        for (int r = 0; r < R; ++r) { s[r] = 0.f;
#pragma unroll
            for (int j = 0; j < 4; ++j) s[r] += v[r][j][0] + v[r][j][1] + v[r][j][2] + v[r][j][3]; }
#pragma unroll
        for (int r = 0; r < R; ++r) mu[r] = wave_sum(s[r]) * (1.0f / DM);
#pragma unroll
        for (int r = 0; r < R; ++r) { q[r] = 0.f;
#pragma unroll
            for (int j = 0; j < 4; ++j) { v[r][j] -= mu[r]; q[r] += v[r][j][0] * v[r][j][0] + v[r][j][1] * v[r][j][1] + v[r][j][2] * v[r][j][2] + v[r][j][3] * v[r][j][3]; } }
#pragma unroll
        for (int r = 0; r < R; ++r) rs[r] = rsqrtf(wave_sum(q[r]) * (1.0f / DM) + 1e-5f);
#pragma unroll
        for (int j = 0; j < 4; ++j) { const int c = j * 256 + F.lane * 4; const f32x4 gv = *(const f32x4*)(g + c), bv = *(const f32x4*)(b + c);
#pragma unroll
            for (int r = 0; r < R; ++r) { const size_t row = (size_t)(row0 + r); const f32x4 o = v[r][j] * rs[r] * gv + bv;
                if (row >= TP) *(f32x4*)(X + row * DM + c) = o * ALPHA;
                u32x2 w; w.x = cvt_pk_bf16(o[0], o[1]); w.y = cvt_pk_bf16(o[2], o[3]); *(u32x2*)(XB + row * DM + c) = w;
                if (final_out && row < MR) __builtin_nontemporal_store(o, (f32x4*)(final_out + row * DM + c)); } }
    }
}

__device__ __forceinline__ void item_attn(const Frame& F, int item) {
    const int l = F.l, qb = item & 63, kvh = (item >> 6) & 1, b = item >> 7, q0 = qb * 64, kp0 = q0 - 128;
    const bf16_t* HB = F.w<bf16_t>(WS_HB); bf16_t* YA = F.w<bf16_t>(WS_YA);
    constexpr int KP = 72, VP = 216, PP = 168;
    bf16_t* Ks = (bf16_t*)F.sm;
    bf16_t* Vt = Ks + 192 * KP;
    bf16_t* Pw = Vt + 64 * VP + F.wave * 16 * PP;
    const size_t rowb = (size_t)b * SEQ;
    __syncthreads();
    for (int e = F.tid; e < 208 * 8; e += NTHR) { const int j = e >> 3, d8 = (e & 7) * 8, pos = kp0 + j;
        u32x4 kw = (u32x4){0u, 0u, 0u, 0u}, vw = kw;
        if (j < 192 && pos >= 0) { const bf16_t* hr = HB + (rowb + pos) * NH; kw = *(const u32x4*)(hr + HC_K + kvh * 64 + d8); vw = *(const u32x4*)(hr + HC_V + kvh * 64 + d8); }
        if (j < 192) *(u32x4*)(Ks + j * KP + d8) = kw;
        const unsigned vv[4] = {vw.x, vw.y, vw.z, vw.w};
#pragma unroll
        for (int i = 0; i < 4; ++i) { Vt[(d8 + 2 * i) * VP + j] = (bf16_t)(vv[i] & 0xFFFFu); Vt[(d8 + 2 * i + 1) * VP + j] = (bf16_t)(vv[i] >> 16); }
        if (qb >= 62 && j >= 128 && j < 192) {
            float kf[8], vf[8]; unpack8(kw, kf); unpack8(vw, vf);
            float* pk = F.p->out + O_PK + ((((size_t)l * NB + b) * 128 + (pos - (SEQ - 128))) * 2 + kvh) * 64 + d8;
            float* pv = F.p->out + O_PV + ((((size_t)l * NB + b) * 128 + (pos - (SEQ - 128))) * 2 + kvh) * 64 + d8;
#pragma unroll
            for (int i = 0; i < 8; ++i) { pk[i] = kf[i]; pv[i] = vf[i]; } }
    }
    __syncthreads();
    const int hh = F.wave >> 1, qh = F.wave & 1, h = kvh * 4 + hh, lane = F.lane, c = lane & 15, quad = lane >> 4;
    const float slope = exp2f(-(float)(h + 1)), sink = F.in(I_SINK)[l * 8 + h];
    for (int mt = 0; mt < 2; ++mt) {
        const int base = qh * 32 + mt * 16;
        const bf16_t* qp = HB + (rowb + q0 + base + c) * NH + HC_Q + h * 64 + quad * 8;
        const bf16x8 a0 = *(const bf16x8*)qp, a1 = *(const bf16x8*)(qp + 32);
        f32x4 s[9];
#pragma unroll
        for (int nt = 0; nt < 9; ++nt) { const bf16_t* kp = Ks + (base + nt * 16 + c) * KP + quad * 8;
            f32x4 acc = (f32x4){0.f, 0.f, 0.f, 0.f};
            acc = __builtin_amdgcn_mfma_f32_16x16x32_bf16(a0, *(const bf16x8*)kp, acc, 0, 0, 0);
            acc = __builtin_amdgcn_mfma_f32_16x16x32_bf16(a1, *(const bf16x8*)(kp + 32), acc, 0, 0, 0);
            s[nt] = acc; }
        float mx[4] = {-1e30f, -1e30f, -1e30f, -1e30f};
#pragma unroll
        for (int nt = 0; nt < 9; ++nt) { const int kpos = kp0 + base + nt * 16 + c;
#pragma unroll
            for (int j = 0; j < 4; ++j) { const int r = quad * 4 + j, dist = 128 + r - nt * 16 - c;
                const bool ok = (dist >= 0) && (dist <= 128) && (kpos >= 0);
                const float v = ok ? s[nt][j] * 0.125f - slope * (float)dist : -1e30f; s[nt][j] = v; mx[j] = fmaxf(mx[j], v); } }
        float den[4];
#pragma unroll
        for (int j = 0; j < 4; ++j) { mx[j] = fmaxf(quad16_max(mx[j]), sink); den[j] = 0.f; }
#pragma unroll
        for (int nt = 0; nt < 9; ++nt)
#pragma unroll
            for (int j = 0; j < 4; ++j) { const float pz = __expf(s[nt][j] - mx[j]); den[j] += pz; Pw[(quad * 4 + j) * PP + nt * 16 + c] = f2bf(pz); }
#pragma unroll
        for (int j = 0; j < 4; ++j) { den[j] = __builtin_amdgcn_rcpf(quad16_sum(den[j]) + __expf(sink - mx[j])); Pw[(quad * 4 + j) * PP + 144 + c] = 0; }
        f32x4 o[4];
#pragma unroll
        for (int nt = 0; nt < 4; ++nt) o[nt] = mma16(Pw, PP, Vt + (nt * 16) * VP + base, VP, 160, (f32x4){0.f, 0.f, 0.f, 0.f}, lane);
#pragma unroll
        for (int nt = 0; nt < 4; ++nt)
#pragma unroll
            for (int j = 0; j < 4; ++j) YA[(rowb + q0 + base + quad * 4 + j) * 512 + h * 64 + nt * 16 + c] = f2bf(o[nt][j] * den[j]);
    }
}

__device__ __forceinline__ void item_attn_dec(const Frame& F, int b) {
    const int l = F.l; const size_t sr = (size_t)TP + b;
    const bf16_t* HB = F.w<bf16_t>(WS_HB); bf16_t* YA = F.w<bf16_t>(WS_YA);
    constexpr int KVP = 129;
    float* KV = (float*)F.sm;
    float* Qs = KV + 129 * KVP;
    float* Ps = Qs + 512;
    const float* ck = F.in(I_CK) + ((size_t)l * MS + b) * 128 * 128; const float* cv = F.in(I_CV) + ((size_t)l * MS + b) * 128 * 128;
    float* ok = F.p->out + O_SK + ((size_t)l * MS + b) * 128 * 128; float* ov = F.p->out + O_SV + ((size_t)l * MS + b) * 128 * 128;
    __syncthreads();
    for (int e0 = F.tid; e0 < 128 * 128; e0 += NTHR * 8) { float v[8];
#pragma unroll
        for (int i = 0; i < 8; ++i) v[i] = __builtin_nontemporal_load(ck + e0 + i * NTHR);
#pragma unroll
        for (int i = 0; i < 8; ++i) { const int e = e0 + i * NTHR, j = e >> 7, cc = e & 127; KV[j * KVP + cc] = v[i]; if (j >= 1) __builtin_nontemporal_store(v[i], ok + e - 128); } }
    if (F.tid < 128) { const float v = bf2f(HB[sr * NH + HC_K + F.tid]); KV[128 * KVP + F.tid] = v; ok[127 * 128 + F.tid] = v; }
    Qs[F.tid] = bf2f(HB[sr * NH + HC_Q + F.tid]);
    { float* mg = F.w<float>(WS_MERGED) + sr * DM; mg[F.tid] = 0.f; mg[512 + F.tid] = 0.f; }
    __syncthreads();
    for (int idx = F.tid; idx < 8 * 129; idx += NTHR) { const int h = idx / 129, j = idx - h * 129, kvh = h >> 2;
        float s = 0.f;
#pragma unroll 8
        for (int d = 0; d < 64; ++d) s += Qs[h * 64 + d] * KV[j * KVP + kvh * 64 + d];
        Ps[h * 132 + j] = s * 0.125f - exp2f(-(float)(h + 1)) * (float)(128 - j); }
    __syncthreads();
    { const int h = F.wave; const float sink = F.in(I_SINK)[l * 8 + h];
      const float s0 = Ps[h * 132 + F.lane], s1 = Ps[h * 132 + 64 + F.lane], s2 = (F.lane == 0) ? Ps[h * 132 + 128] : -1e30f;
      const float m = fmaxf(wave_max(fmaxf(fmaxf(s0, s1), s2)), sink);
      const float p0 = __expf(s0 - m), p1 = __expf(s1 - m), p2 = (F.lane == 0) ? __expf(s2 - m) : 0.f;
      const float den = wave_sum(p0 + p1 + p2) + __expf(sink - m), inv = 1.0f / den;
      Ps[h * 132 + F.lane] = p0 * inv; Ps[h * 132 + 64 + F.lane] = p1 * inv; if (F.lane == 0) Ps[h * 132 + 128] = p2 * inv; }
    __syncthreads();
    for (int e0 = F.tid; e0 < 128 * 128; e0 += NTHR * 8) { float v[8];
#pragma unroll
        for (int i = 0; i < 8; ++i) v[i] = __builtin_nontemporal_load(cv + e0 + i * NTHR);
#pragma unroll
        for (int i = 0; i < 8; ++i) { const int e = e0 + i * NTHR, j = e >> 7, cc = e & 127; KV[j * KVP + cc] = v[i]; if (j >= 1) __builtin_nontemporal_store(v[i], ov + e - 128); } }
    if (F.tid < 128) { const float v = bf2f(HB[sr * NH + HC_V + F.tid]); KV[128 * KVP + F.tid] = v; ov[127 * 128 + F.tid] = v; }
    __syncthreads();
    { const int h = F.tid >> 6, d = F.tid & 63, kvh = h >> 2; float o = 0.f;
      for (int j = 0; j < 129; ++j) o += Ps[h * 132 + j] * KV[j * KVP + kvh * 64 + d];
      YA[sr * 512 + F.tid] = f2bf(o); }
}

__device__ __forceinline__ void item_ssd_a(const Frame& F, int item) {
    const int l = F.l, g = item & 1, c = (item >> 1) & 63, b = item >> 7, t0 = c * 64;
    const size_t r0 = (size_t)b * SEQ + t0;
    const bf16_t* HB = F.w<bf16_t>(WS_HB); bf16_t* ACT = F.w<bf16_t>(WS_ACT);
    constexpr int P = 72;
    bf16_t* Bn = (bf16_t*)F.sm;
    bf16_t* Cn = Bn + 64 * P;
    bf16_t* xT = Cn + 64 * P;
    bf16_t* Wp = xT + 4 * 64 * P + F.wave * 32 * P;
    float* a_s = (float*)(xT + 4 * 64 * P + 8 * 32 * P);
    float* dt_s = a_s + 256;
    __syncthreads();
    if (F.wave < 4) { const int h = g * 4 + F.wave, t = F.lane;
        const float dt = softplusf_(bf2f(HB[(r0 + t) * NH + HC_DT + h]) + F.in(I_DTB)[l * 8 + h]);
        const float A = -__expf(F.in(I_ALOG)[l * 8 + h]);
        const float a = wave_incl_scan(dt * A, t);
        a_s[t * 4 + F.wave] = a; dt_s[t * 4 + F.wave] = dt;
        F.w<float>(WS_ACUM)[(r0 + t) * 8 + h] = a;
        if (t == 63) F.w<float>(WS_DECS)[((size_t)b * 64 + c) * 8 + h] = __expf(a); }
    const float* cw = F.in(I_CONVW) + (size_t)l * 4 * 768; const float* cb = F.in(I_CONVB) + (size_t)l * 768;
    for (int e = F.tid; e < 48 * 64; e += NTHR) { const int t = e & 63, cg8 = e >> 6;
        const int ch = cg8 < 32 ? g * 256 + cg8 * 8 : (cg8 < 40 ? 512 + g * 64 + (cg8 - 32) * 8 : 640 + g * 64 + (cg8 - 40) * 8);
        float acc[8];
#pragma unroll
        for (int i = 0; i < 8; ++i) acc[i] = cb[ch + i];
#pragma unroll
        for (int w = 0; w < 4; ++w) { const int tt = t0 + t - 3 + w;
            if (tt >= 0) { float xv[8]; unpack8(*(const u32x4*)(HB + ((size_t)b * SEQ + tt) * NH + HC_XBC + ch), xv);
                const f32x4 w0 = *(const f32x4*)(cw + w * 768 + ch), w1 = *(const f32x4*)(cw + w * 768 + ch + 4);
#pragma unroll
                for (int i = 0; i < 4; ++i) { acc[i] += xv[i] * w0[i]; acc[4 + i] += xv[4 + i] * w1[i]; } } }
        bf16_t ob[8];
#pragma unroll
        for (int i = 0; i < 8; ++i) ob[i] = f2bf(siluf_(acc[i]));
        u32x4 w; w.x = ob[0] | ((unsigned)ob[1] << 16); w.y = ob[2] | ((unsigned)ob[3] << 16); w.z = ob[4] | ((unsigned)ob[5] << 16); w.w = ob[6] | ((unsigned)ob[7] << 16);
        *(u32x4*)(ACT + (r0 + t) * 768 + ch) = w;
        if (cg8 < 32) { const int hh = cg8 >> 3, p0 = (cg8 & 7) * 8;
#pragma unroll
            for (int i = 0; i < 8; ++i) xT[(hh * 64 + p0 + i) * P + t] = ob[i]; }
        else if (cg8 < 40) *(u32x4*)(Bn + t * P + (cg8 - 32) * 8) = w;
        else *(u32x4*)(Cn + t * P + (cg8 - 40) * 8) = w;
        if (c == 63 && t >= 61) {
            float xv[8]; unpack8(*(const u32x4*)(HB + (r0 + t) * NH + HC_XBC + ch), xv);
            float* pc = F.p->out + O_PC + (((size_t)l * NB + b) * 3 + (t - 61)) * 768 + ch;
#pragma unroll
            for (int i = 0; i < 8; ++i) pc[i] = xv[i]; }
    }
    __syncthreads();
    const int hh = F.wave >> 1, th = F.wave & 1, h = g * 4 + hh, lane = F.lane, cc = lane & 15, quad = lane >> 4;
#pragma unroll
    for (int mt = 0; mt < 2; ++mt)
#pragma unroll
        for (int nt = 0; nt < 4; ++nt) {
            f32x4 gt = (f32x4){0.f, 0.f, 0.f, 0.f};
            if (nt <= th * 2 + mt) gt = mma16(Cn + (th * 32 + mt * 16) * P, P, Bn + (nt * 16) * P, P, 64, gt, lane);
            const int s = nt * 16 + cc; const float as = a_s[s * 4 + hh], dts = dt_s[s * 4 + hh];
#pragma unroll
            for (int j = 0; j < 4; ++j) { const int t = th * 32 + mt * 16 + quad * 4 + j;
                const float w = (s <= t) ? gt[j] * __expf(a_s[t * 4 + hh] - as) * dts : 0.f;
                Wp[(mt * 16 + quad * 4 + j) * P + s] = f2bf(w); } }
    bf16_t* Y = F.w<bf16_t>(WS_YSSD);
#pragma unroll
    for (int mt = 0; mt < 2; ++mt)
#pragma unroll
        for (int nt = 0; nt < 4; ++nt) {
            const f32x4 y = mma16(xT + (hh * 64 + nt * 16) * P, P, Wp + (mt * 16) * P, P, 64, (f32x4){0.f, 0.f, 0.f, 0.f}, lane);
            u32x2 w; w.x = pk_bf16_c(y[0], y[1]); w.y = pk_bf16_c(y[2], y[3]); *(u32x2*)(Y + (r0 + th * 32 + mt * 16 + cc) * 512 + h * 64 + nt * 16 + quad * 4) = w; }
    { const float al = a_s[63 * 4 + hh];
      for (int e = lane; e < 32 * 64; e += 64) { const int s = e & 63, nl = e >> 6;
          Wp[nl * P + s] = f2bf(bf2f(Bn[s * P + th * 32 + nl]) * __expf(al - a_s[s * 4 + hh]) * dt_s[s * 4 + hh]); } }
    bf16_t* CS = F.w<bf16_t>(WS_CS) + (((size_t)b * 64 + c) * 8 + h) * 4096;
#pragma unroll
    for (int mt = 0; mt < 4; ++mt)
#pragma unroll
        for (int nt = 0; nt < 2; ++nt) {
            const f32x4 v = mma16(Wp + (nt * 16) * P, P, xT + (hh * 64 + mt * 16) * P, P, 64, (f32x4){0.f, 0.f, 0.f, 0.f}, lane);
            u32x2 w; w.x = pk_bf16_c(v[0], v[1]); w.y = pk_bf16_c(v[2], v[3]); *(u32x2*)(CS + (mt * 16 + cc) * 64 + th * 32 + nt * 16 + quad * 4) = w; }
}

__device__ __forceinline__ void item_ssd_dec(const Frame& F, int b) {
    const int l = F.l; const size_t sr = (size_t)TP + b;
    const bf16_t* HB = F.w<bf16_t>(WS_HB);
    float* act = (float*)F.sm;
    float* ys = act + 768;
    float* red = ys + 512;
    __syncthreads();
    const float* cw = F.in(I_CONVW) + (size_t)l * 4 * 768; const float* cb = F.in(I_CONVB) + (size_t)l * 768;
    const float* sc = F.in(I_SCONV) + ((size_t)l * MS + b) * 3 * 768; float* oc = F.p->out + O_SC + ((size_t)l * MS + b) * 3 * 768;
    for (int ch = F.tid; ch < 768; ch += NTHR) { const float o0 = sc[ch], o1 = sc[768 + ch], o2 = sc[1536 + ch], nw = bf2f(HB[sr * NH + HC_XBC + ch]);
        act[ch] = siluf_(o0 * cw[ch] + o1 * cw[768 + ch] + o2 * cw[1536 + ch] + nw * cw[2304 + ch] + cb[ch]);
        oc[ch] = o1; oc[768 + ch] = o2; oc[1536 + ch] = nw; }
    __syncthreads();
    { const int h = F.wave, g = h >> 2, n = F.lane;
      const float dt = softplusf_(bf2f(HB[sr * NH + HC_DT + h]) + F.in(I_DTB)[l * 8 + h]);
      const float dA = __expf(dt * -__expf(F.in(I_ALOG)[l * 8 + h]));
      const float Bv = act[512 + g * 64 + n] * dt, Cv = act[640 + g * 64 + n], Dh = F.in(I_DSKIP)[l * 8 + h];
      const float* s0 = F.in(I_SSSM) + (((size_t)l * MS + b) * 8 + h) * 4096; float* s1 = F.p->out + O_SSSM + (((size_t)l * MS + b) * 8 + h) * 4096;
#pragma unroll 16
      for (int p = 0; p < 64; ++p) { const float x = act[h * 64 + p]; const float hT = dA * __builtin_nontemporal_load(s0 + p * 64 + n) + x * Bv; __builtin_nontemporal_store(hT, s1 + p * 64 + n);
          const float y = wave_sum(Cv * hT);
          if (n == 0) ys[h * 64 + p] = (y + Dh * x) * siluf_(bf2f(HB[sr * NH + HC_Z + h * 64 + p])); } }
    __syncthreads();
    { const float y = ys[F.tid]; const float q = wave_sum(y * y); if (F.lane == 0) red[F.wave] = q; __syncthreads();
      float tot = 0.f;
#pragma unroll
      for (int i = 0; i < 8; ++i) tot += red[i];
      F.w<bf16_t>(WS_YM)[sr * 512 + F.tid] = f2bf(y * rsqrtf(tot * (1.0f / 512.f) + 1e-6f) * F.in(I_SNW)[l * 512 + F.tid]); }
}

__device__ __forceinline__ void item_ssd_c(const Frame& F, int item) {
    const int l = F.l, c = item & 63, b = item >> 6; const size_t r0 = (size_t)b * SEQ + c * 64;
    const bf16_t* HB = F.w<bf16_t>(WS_HB); const bf16_t* ACT = F.w<bf16_t>(WS_ACT);
    constexpr int P = 72;
    bf16_t* Cn = (bf16_t*)F.sm;
    bf16_t* Hn = Cn + 2 * 64 * P + F.wave * 64 * P;
    float* ssq = (float*)(Cn + 2 * 64 * P + 8 * 64 * P);
    const int h = F.wave, g = h >> 2, lane = F.lane, cc = lane & 15, quad = lane >> 4;
    __syncthreads();
    for (int e = F.tid; e < 2 * 64 * 8; e += NTHR) { const int n8 = (e & 7) * 8, t = (e >> 3) & 63, gg = e >> 9;
        *(u32x4*)(Cn + (gg * 64 + t) * P + n8) = *(const u32x4*)(ACT + (r0 + t) * 768 + 640 + gg * 64 + n8); }
    { const bf16_t* hs = F.w<bf16_t>(WS_CS) + (((size_t)b * 64 + c) * 8 + h) * 4096;
      for (int e = lane; e < 64 * 8; e += 64) { const int p = e >> 3, n8 = (e & 7) * 8; *(u32x4*)(Hn + p * P + n8) = *(const u32x4*)(hs + p * 64 + n8); } }
    __syncthreads();
    const float Dh = F.in(I_DSKIP)[l * 8 + h];
    const bf16_t* Y = F.w<bf16_t>(WS_YSSD); const float* AC = F.w<float>(WS_ACUM);
    f32x4 y[4][4];
#pragma unroll
    for (int mt = 0; mt < 4; ++mt) { const size_t row = r0 + mt * 16 + cc;
        const float ea = __expf(AC[row * 8 + h]); float q = 0.f;
#pragma unroll
        for (int nt = 0; nt < 4; ++nt) { const f32x4 v = mma16(Hn + (nt * 16) * P, P, Cn + (g * 64 + mt * 16) * P, P, 64, (f32x4){0.f, 0.f, 0.f, 0.f}, lane);
            const int col = h * 64 + nt * 16 + quad * 4;
            const u32x2 yw = *(const u32x2*)(Y + row * 512 + col); const float yi[4] = {__uint_as_float(yw.x << 16), __uint_as_float(yw.x & 0xFFFF0000u), __uint_as_float(yw.y << 16), __uint_as_float(yw.y & 0xFFFF0000u)};
            const u32x2 xw = *(const u32x2*)(ACT + row * 768 + col), zw = *(const u32x2*)(HB + row * NH + HC_Z + col);
            const float xv[4] = {__uint_as_float(xw.x << 16), __uint_as_float(xw.x & 0xFFFF0000u), __uint_as_float(xw.y << 16), __uint_as_float(xw.y & 0xFFFF0000u)};
            const float zv[4] = {__uint_as_float(zw.x << 16), __uint_as_float(zw.x & 0xFFFF0000u), __uint_as_float(zw.y << 16), __uint_as_float(zw.y & 0xFFFF0000u)};
#pragma unroll
            for (int j = 0; j < 4; ++j) { float yy = (yi[j] + ea * v[j] + Dh * xv[j]) * siluf_(zv[j]); y[mt][nt][j] = yy; q += yy * yy; } }
        q += __shfl_xor(q, 16); q += __shfl_xor(q, 32);
        if (quad == 0) ssq[h * 64 + mt * 16 + cc] = q; }
    __syncthreads();
    bf16_t* YM = F.w<bf16_t>(WS_YM); const float* nw = F.in(I_SNW) + l * 512;
#pragma unroll
    for (int mt = 0; mt < 4; ++mt) { const int t = mt * 16 + cc; float tot = 0.f;
#pragma unroll
        for (int i = 0; i < 8; ++i) tot += ssq[i * 64 + t];
        const float rstd = rsqrtf(tot * (1.0f / 512.f) + 1e-6f);
#pragma unroll
        for (int nt = 0; nt < 4; ++nt) { const int col = h * 64 + nt * 16 + quad * 4; const f32x4 w4 = *(const f32x4*)(nw + col);
            u32x2 w; w.x = cvt_pk_bf16(y[mt][nt][0] * rstd * w4[0], y[mt][nt][1] * rstd * w4[1]); w.y = cvt_pk_bf16(y[mt][nt][2] * rstd * w4[2], y[mt][nt][3] * rstd * w4[3]);
            *(u32x2*)(YM + (r0 + t) * 512 + col) = w; } }
}

__device__ __forceinline__ void item_hg_a(const Frame& F, int item) {
    const int l = F.l, c = item & 63, hd = (item >> 6) & 3, b = item >> 8; const size_t r0 = (size_t)b * SEQ + c * 64;
    const bf16_t* HB = F.w<bf16_t>(WS_HB);
    constexpr int QP = 130, BP = 129, P = 72;
    bf16_t* q_s = (bf16_t*)F.sm;
    bf16_t* k_s = q_s + 64 * QP;
    float* bc = (float*)(k_s + 64 * QP);
    bf16_t* att = (bf16_t*)(bc + 64 * BP);
    bf16_t* iT = att + 64 * P;
    bf16_t* keT = iT + 128 * P;
    const int lane = F.lane, cc = lane & 15, quad = lane >> 4;
    float* lbs = (float*)(keT + 128 * P);
    __syncthreads();
    if (F.tid < 128) lbs[F.tid] = lb_of(F.in(I_LBL), l, hd * 128 + F.tid);
    __syncthreads();
    for (int e = F.tid; e < 64 * 16; e += NTHR) { const int t = e >> 4, k8 = (e & 15) * 8; const bf16_t* hr = HB + (r0 + t) * NH + hd * 128 + k8;
        float qv[8], fv[8]; unpack8(*(const u32x4*)(hr + HC_HQ), qv); unpack8(*(const u32x4*)(hr + HC_HF), fv);
        const u32x4 iw = *(const u32x4*)(hr + HC_HI); const unsigned iv[4] = {iw.x, iw.y, iw.z, iw.w};
#pragma unroll
        for (int i = 0; i < 8; ++i) { const float lbv = lbs[k8 + i];
            const float sg = __builtin_amdgcn_rcpf(1.0f + __expf(-fv[i])), sgn = __builtin_amdgcn_rcpf(1.0f + __expf(fv[i]));
            q_s[t * QP + k8 + i] = f2bf(siluf_(qv[i])); k_s[t * QP + k8 + i] = f2bf((1.0f - lbv) * sgn);
            bc[t * BP + k8 + i] = __logf(lbv + (1.0f - lbv) * sg); }
#pragma unroll
        for (int i = 0; i < 4; ++i) { iT[(k8 + 2 * i) * P + t] = (bf16_t)(iv[i] & 0xFFFFu); iT[(k8 + 2 * i + 1) * P + t] = (bf16_t)(iv[i] >> 16); } }
    __syncthreads();
    for (int k = F.wave; k < 128; k += 8) bc[lane * BP + k] = wave_incl_scan(bc[lane * BP + k], lane);
    __syncthreads();
    constexpr int DP = 136;
    bf16_t* qd = (bf16_t*)(lbs + 128);
    bf16_t* kd = keT;
    for (int e = F.tid; e < 64 * 128; e += NTHR) { const int r = e >> 7, k = e & 127;
        const int ref = r < 32 ? 31 : (r < 48 ? 15 : 47), t = r < 32 ? 32 + r : (r < 48 ? r - 16 : r), sx = r < 32 ? r : (r < 48 ? r - 32 : r - 16);
        const float br = bc[ref * BP + k];
        qd[r * DP + k] = f2bf(bf2f(q_s[t * QP + k]) * __expf(bc[t * BP + k] - br));
        kd[r * DP + k] = f2bf(bf2f(k_s[sx * QP + k]) * __expf(br - bc[sx * BP + k])); }
    { const int idx = F.tid, B = idx / 136, p = idx - B * 136;
      int i = (int)((sqrtf(8.0f * (float)p + 1.0f) - 1.0f) * 0.5f); while ((i + 1) * (i + 2) / 2 <= p) ++i; while (i * (i + 1) / 2 > p) --i;
      const int j = p - i * (i + 1) / 2, t = 16 * B + i, sx = 16 * B + j; float a = 0.f;
#pragma unroll 4
      for (int k = 0; k < 128; ++k) a += bf2f(q_s[t * QP + k]) * bf2f(k_s[sx * QP + k]) * __expf(bc[t * BP + k] - bc[sx * BP + k]);
      att[t * P + sx] = f2bf(a); }
    { const int p = 512 + (F.tid >> 4) - 3 * 136, ks = (F.tid & 15) * 8;
      int i = (int)((sqrtf(8.0f * (float)p + 1.0f) - 1.0f) * 0.5f); while ((i + 1) * (i + 2) / 2 <= p) ++i; while (i * (i + 1) / 2 > p) --i;
      const int j = p - i * (i + 1) / 2, t = 48 + i, sx = 48 + j; float a = 0.f;
#pragma unroll
      for (int k = ks; k < ks + 8; ++k) a += bf2f(q_s[t * QP + k]) * bf2f(k_s[sx * QP + k]) * __expf(bc[t * BP + k] - bc[sx * BP + k]);
      a = quad16_sum(a); if ((F.tid & 15) == 0) att[t * P + sx] = f2bf(a); }
    for (int e = F.tid; e < 64 * 64; e += NTHR) { const int t = e >> 6, sx = e & 63; if (sx > t) att[t * P + sx] = 0; }
    __syncthreads();
    if (F.wave < 6) { const int w = F.wave; const int qr = w < 4 ? (w >> 1) * 16 : (w == 4 ? 32 : 48), kr = w < 4 ? (w & 1) * 16 : (w == 4 ? 32 : 48);
        const int t0 = w < 4 ? 32 + (w >> 1) * 16 : (w == 4 ? 16 : 48), s0 = w < 4 ? (w & 1) * 16 : (w == 4 ? 0 : 32);
        const f32x4 v = mma16(qd + qr * DP, DP, kd + kr * DP, DP, 128, (f32x4){0.f, 0.f, 0.f, 0.f}, lane);
#pragma unroll
        for (int j = 0; j < 4; ++j) att[(t0 + quad * 4 + j) * P + s0 + cc] = f2bf(v[j]); }
    __syncthreads();
    bf16_t* QE = F.w<bf16_t>(WS_QE);
    for (int e = F.tid; e < 64 * 128; e += NTHR) { const int s = e >> 7, k = e & 127; const float bb = bc[s * BP + k];
        keT[k * P + s] = f2bf(bf2f(k_s[s * QP + k]) * __expf(bc[63 * BP + k] - bb));
        QE[(r0 + s) * 512 + hd * 128 + k] = f2bf(bf2f(q_s[s * QP + k]) * __expf(bb)); }
    if (F.tid < 128) F.w<float>(WS_DECH)[(((size_t)b * 4 + hd) * 64 + c) * 128 + F.tid] = __expf(bc[63 * BP + F.tid]);
    __syncthreads();
    bf16_t* OH = F.w<bf16_t>(WS_OHG);
    { const int mt = F.wave >> 1;
#pragma unroll
      for (int n4 = 0; n4 < 4; ++n4) { const int nt = (F.wave & 1) * 4 + n4;
          const f32x4 v = mma16(iT + (nt * 16) * P, P, att + (mt * 16) * P, P, 64, (f32x4){0.f, 0.f, 0.f, 0.f}, lane);
          u32x2 w; w.x = pk_bf16_c(v[0], v[1]); w.y = pk_bf16_c(v[2], v[3]); *(u32x2*)(OH + (r0 + mt * 16 + cc) * 512 + hd * 128 + nt * 16 + quad * 4) = w; } }
    bf16_t* KC = F.w<bf16_t>(WS_KC) + (((size_t)b * 4 + hd) * 64 + c) * 16384;
#pragma unroll
    for (int nt = 0; nt < 8; ++nt) { const f32x4 v = mma16(keT + (F.wave * 16) * P, P, iT + (nt * 16) * P, P, 64, (f32x4){0.f, 0.f, 0.f, 0.f}, lane);
        { u32x2 w; w.x = pk_bf16_c(v[0], v[1]); w.y = pk_bf16_c(v[2], v[3]); *(u32x2*)(KC + (nt * 16 + cc) * 128 + F.wave * 16 + quad * 4) = w; } }
}

__device__ __forceinline__ void item_hg_c(const Frame& F, int item) {
    const int l = F.l, c = item & 63, hd = (item >> 6) & 3, b = item >> 8; const size_t r0 = (size_t)b * SEQ + c * 64;
    const bf16_t* HB = F.w<bf16_t>(WS_HB);
    constexpr int P = 136;
    bf16_t* qe = (bf16_t*)F.sm;
    bf16_t* ST = qe + 64 * P;
    float* ssq = (float*)(ST + 128 * P);
    const int lane = F.lane, cc = lane & 15, quad = lane >> 4;
    __syncthreads();
    const bf16_t* QE = F.w<bf16_t>(WS_QE);
    for (int e = F.tid; e < 64 * 16; e += NTHR) { const int t = e >> 4, k8 = (e & 15) * 8; *(u32x4*)(qe + t * P + k8) = *(const u32x4*)(QE + (r0 + t) * 512 + hd * 128 + k8); }
    const bf16_t* Sp = F.w<bf16_t>(WS_KC) + (((size_t)b * 4 + hd) * 64 + c) * 16384;
    for (int e = F.tid; e < 128 * 16; e += NTHR) { const int v = e >> 4, k8 = (e & 15) * 8; *(u32x4*)(ST + v * P + k8) = *(const u32x4*)(Sp + v * 128 + k8); }
    __syncthreads();
    const int mt = F.wave >> 1, nh = F.wave & 1;
    const bf16_t* OH = F.w<bf16_t>(WS_OHG); const size_t row = r0 + mt * 16 + cc;
    f32x4 o[4]; float q = 0.f;
#pragma unroll
    for (int n4 = 0; n4 < 4; ++n4) { const int nt = nh * 4 + n4;
        o[n4] = mma16(ST + (nt * 16) * P, P, qe + (mt * 16) * P, P, 128, (f32x4){0.f, 0.f, 0.f, 0.f}, lane);
        { const u32x2 ow = *(const u32x2*)(OH + row * 512 + hd * 128 + nt * 16 + quad * 4); o[n4][0] += __uint_as_float(ow.x << 16); o[n4][1] += __uint_as_float(ow.x & 0xFFFF0000u); o[n4][2] += __uint_as_float(ow.y << 16); o[n4][3] += __uint_as_float(ow.y & 0xFFFF0000u); }
        q += o[n4][0] * o[n4][0] + o[n4][1] * o[n4][1] + o[n4][2] * o[n4][2] + o[n4][3] * o[n4][3]; }
    q += __shfl_xor(q, 16); q += __shfl_xor(q, 32);
    if (quad == 0) ssq[nh * 64 + mt * 16 + cc] = q;
    __syncthreads();
    bf16_t* YH = F.w<bf16_t>(WS_YH); const float* nw = F.in(I_HNW) + l * 128;
    { const int t = mt * 16 + cc; const float rstd = rsqrtf((ssq[t] + ssq[64 + t]) * (1.0f / 128.f) + 1e-6f);
#pragma unroll
      for (int n4 = 0; n4 < 4; ++n4) { const int v0 = (nh * 4 + n4) * 16 + quad * 4; const f32x4 w4 = *(const f32x4*)(nw + v0);
          const u32x2 gw = *(const u32x2*)(HB + row * NH + HC_HG + hd * 128 + v0);
          const float g0 = siluf_(__uint_as_float(gw.x << 16)), g1 = siluf_(__uint_as_float(gw.x & 0xFFFF0000u)), g2 = siluf_(__uint_as_float(gw.y << 16)), g3 = siluf_(__uint_as_float(gw.y & 0xFFFF0000u));
          u32x2 w; w.x = cvt_pk_bf16(o[n4][0] * rstd * w4[0] * g0, o[n4][1] * rstd * w4[1] * g1); w.y = cvt_pk_bf16(o[n4][2] * rstd * w4[2] * g2, o[n4][3] * rstd * w4[3] * g3);
          *(u32x2*)(YH + row * 512 + hd * 128 + v0) = w; } }
}

__device__ __forceinline__ void item_hg_dec(const Frame& F, int item) {
    const int l = F.l, hd = item & 3, b = item >> 2; const size_t sr = (size_t)TP + b;
    const bf16_t* HB = F.w<bf16_t>(WS_HB);
    float* fq = (float*)F.sm;
    float* op = fq + 384;
    float* red = op + 512;
    __syncthreads();
    if (F.tid < 128) { const int k = F.tid; const float lbv = lb_of(F.in(I_LBL), l, hd * 128 + k); const float fl = bf2f(HB[sr * NH + HC_HF + hd * 128 + k]);
        fq[k] = lbv + (1.0f - lbv) / (1.0f + __expf(-fl)); fq[128 + k] = (1.0f - lbv) / (1.0f + __expf(fl)); fq[256 + k] = siluf_(bf2f(HB[sr * NH + HC_HQ + hd * 128 + k])); }
    __syncthreads();
    const int kq = F.tid >> 7, v = F.tid & 127; const float iv = bf2f(HB[sr * NH + HC_HI + hd * 128 + v]);
    const float* s0 = F.in(I_SHG) + (((size_t)l * MS + b) * 4 + hd) * 16384; float* s1 = F.p->out + O_SHG + (((size_t)l * MS + b) * 4 + hd) * 16384;
    float o = 0.f;
#pragma unroll 16
    for (int k = kq * 32; k < kq * 32 + 32; ++k) { const float sn = fq[k] * __builtin_nontemporal_load(s0 + k * 128 + v) + fq[128 + k] * iv; __builtin_nontemporal_store(sn, s1 + k * 128 + v); o += fq[256 + k] * sn; }
    op[kq * 128 + v] = o;
    __syncthreads();
    if (F.tid < 128) { const float ov = op[v] + op[128 + v] + op[256 + v] + op[384 + v]; const float q = wave_sum(ov * ov); if (F.lane == 0) red[F.wave] = q; op[v] = ov; }
    __syncthreads();
    if (F.tid < 128) { const float rstd = rsqrtf((red[0] + red[1]) * (1.0f / 128.f) + 1e-6f);
        F.w<bf16_t>(WS_YH)[sr * 512 + hd * 128 + v] = f2bf(op[v] * rstd * F.in(I_HNW)[l * 128 + v] * siluf_(bf2f(HB[sr * NH + HC_HG + hd * 128 + v]))); }
}

__device__ __forceinline__ void phase_scan(const Frame& F) {
    const int l = F.l;
    if (F.tid < 256) { unsigned* CS = F.w<unsigned>(WS_CS); const float* DE = F.w<float>(WS_DECS);
      for (int e = F.bid * 256 + F.tid; e < 4 * 8 * 2048; e += F.G * 256) { const int b = e >> 14, h = (e >> 11) & 7, pn2 = e & 2047; float S0 = 0.f, S1 = 0.f;
          unsigned* base = CS + ((size_t)b * 64 * 8 + h) * 2048 + pn2; const float* db = DE + (size_t)b * 64 * 8 + h;
          for (int c0 = 0; c0 < 64; c0 += 16) { unsigned v[16]; float d[16];
#pragma unroll
              for (int i = 0; i < 16; ++i) { v[i] = base[(size_t)(c0 + i) * 8 * 2048]; d[i] = db[(c0 + i) * 8]; }
#pragma unroll
              for (int i = 0; i < 16; ++i) { base[(size_t)(c0 + i) * 8 * 2048] = cvt_pk_bf16(S0, S1); S0 = d[i] * S0 + __uint_as_float(v[i] << 16); S1 = d[i] * S1 + __uint_as_float(v[i] & 0xFFFF0000u); } }
          *(float2*)(F.p->out + O_PSSM + (((size_t)l * NB + b) * 8 + h) * 4096 + pn2 * 2) = make_float2(S0, S1); } }
    { unsigned* KC = F.w<unsigned>(WS_KC); const float* DE = F.w<float>(WS_DECH); const int gt = F.bid * NTHR + F.tid, gn = F.G * NTHR;
      for (int e = gt; e < 4 * 4 * 8192; e += gn) { const int bh = e >> 13, kv = (e & 8191) * 2, k = kv & 127, vv = kv >> 7; float S0 = 0.f, S1 = 0.f;
          unsigned* base = KC + (size_t)bh * 64 * 8192 + (kv >> 1); const float* db = DE + (size_t)bh * 64 * 128 + k;
          for (int c0 = 0; c0 < 64; c0 += 16) { unsigned v[16]; float2 d[16];
#pragma unroll
              for (int i = 0; i < 16; ++i) { v[i] = base[(size_t)(c0 + i) * 8192]; d[i] = *(const float2*)(db + (c0 + i) * 128); }
#pragma unroll
              for (int i = 0; i < 16; ++i) { base[(size_t)(c0 + i) * 8192] = cvt_pk_bf16(S0, S1); S0 = d[i].x * S0 + __uint_as_float(v[i] << 16); S1 = d[i].y * S1 + __uint_as_float(v[i] & 0xFFFF0000u); } }
          float* po = F.p->out + O_PHG + ((size_t)l * 16 + bh) * 16384; po[k * 128 + vv] = S0; po[(k + 1) * 128 + vv] = S1; } }
}

template <bool A_F32, int MODE>
__device__ __forceinline__ void skinny_unit(const Frame& F, const void* A, int lda, const bf16_t* Bt, int ldb, int kbeg, int klen, int n0, float* out, float scale, const bf16_t* gate) {
    const int m0 = F.wave * 16, r = F.lane & 15, q = F.lane >> 4;
    f32x4 acc = (f32x4){0.f, 0.f, 0.f, 0.f};
    const bf16_t* bp = Bt + (size_t)(n0 + r) * ldb + kbeg + q * 8;
    if (!A_F32) { const bf16_t* ap = (const bf16_t*)A + (size_t)(m0 + r) * lda + kbeg + q * 8;
#pragma unroll 8
        for (int k = 0; k < klen; k += 32) acc = __builtin_amdgcn_mfma_f32_16x16x32_bf16(*(const bf16x8*)(ap + k), *(const bf16x8*)(bp + k), acc, 0, 0, 0); }
    else { const float* ap = (const float*)A + (size_t)(m0 + r) * lda + kbeg + q * 8;
#pragma unroll 4
        for (int k = 0; k < klen; k += 32) { const f32x4 x0 = *(const f32x4*)(ap + k), x1 = *(const f32x4*)(ap + k + 4);
            u32x4 w; w.x = cvt_pk_bf16(x0[0], x0[1]); w.y = cvt_pk_bf16(x0[2], x0[3]); w.z = cvt_pk_bf16(x1[0], x1[1]); w.w = cvt_pk_bf16(x1[2], x1[3]);
            bf16x8 a; __builtin_memcpy(&a, &w, 16);
            acc = __builtin_amdgcn_mfma_f32_16x16x32_bf16(a, *(const bf16x8*)(bp + k), acc, 0, 0, 0); } }
#pragma unroll
    for (int j = 0; j < 4; ++j) { const int row = m0 + q * 4 + j, col = n0 + r;
        float v = acc[j] * scale;
        if (MODE == 1) v = acc[j] * sigmoidf_(bf2f(gate[(size_t)row * NH + col]));
        atomicAdd(out + (size_t)row * DM + col, v); }
}

__global__ void __launch_bounds__(NTHR, 2) fwd_megakernel(Params prm) {
    extern __shared__ __attribute__((aligned(16))) unsigned char lds[];
    cg::grid_group grid = cg::this_grid();
    Frame F; F.p = &prm; F.ws = prm.ws; F.sm = lds; F.tid = threadIdx.x; F.lane = F.tid & 63; F.wave = __builtin_amdgcn_readfirstlane(F.tid >> 6); F.G = gridDim.x; F.bid = blockIdx.x; F.l = 0;
    PG8_LAS unsigned char* glds = (PG8_LAS unsigned char*)lds;
    if (threadIdx.x < 4) ((volatile LAS unsigned*)(glds + LDS_GEMM))[threadIdx.x] = 0u;
    __syncthreads();
    XcdBarrier xbar = xcd_barrier_post((unsigned*)(prm.ws + WS_BAR), (volatile LAS unsigned*)(glds + LDS_GEMM));
#define REFRESH() do { int t_ = threadIdx.x; asm volatile("" : "+v"(t_)); F.tid = t_; F.lane = t_ & 63; F.wave = __builtin_amdgcn_readfirstlane(t_ >> 6); } while (0)
    for (int l = 0; l < 4; ++l) {
        F.l = l;
        if (l == 0) { REFRESH(); phase_convert(F); grid.sync(); }
        for (int f = 0; f < 2; ++f) {
            if (f == 1) {
                { pg8::Gemm g{F.w<bf16_t>(WS_XB), F.w<bf16_t>(WS_WIN), MP, NH, 1024}; pg8::StaticOrder S; S.init(MP, NH, F.G, F.bid);
                  EpiBiasBf16 E{F.w<bf16_t>(WS_HB), F.w<float>(WS_BIAS)}; REFRESH();
                  { const int nb = (MP / 256) * (NH / 256) % F.G; if (nb && F.bid >= nb) convert_tasks(F, CT_E2, CT_E5, F.bid - nb, F.G - nb); }
                  REFRESH(); pg8::gemm_phase(glds, g, S, E, F.tid); }
                xcd_barrier(xbar);
                for (int it = F.bid; it < 2816; it += F.G) { REFRESH();
                    if (it < 512) item_attn(F, it); else if (it < 1024) item_ssd_a(F, it - 512); else if (it < 2048) item_hg_a(F, it - 1024);
                    else if (it < 2176) item_attn_dec(F, it - 2048); else if (it < 2304) item_ssd_dec(F, it - 2176); else item_hg_dec(F, it - 2304); }
                xcd_barrier(xbar);
                REFRESH(); phase_scan(F);
                xcd_barrier(xbar);
                for (int it = F.bid; it < 1280; it += F.G) { REFRESH(); if (it < 256) item_ssd_c(F, it); else item_hg_c(F, it - 256); }
                __syncthreads();
                xcd_barrier(xbar);
                { pg8::StaticOrder S; S.init(TP, 1024, F.G, F.bid);
                  { pg8::Gemm g{F.w<bf16_t>(WS_YA), F.w<bf16_t>(WS_WBR), TP, 1024, 512};
                    EpiMerge<0> E{F.w<float>(WS_MERGED), F.w<bf16_t>(WS_MB), F.w<bf16_t>(WS_HB), HC_GATE}; REFRESH(); pg8::gemm_phase(glds, g, S, E, F.tid); }
                  { pg8::Gemm g{F.w<bf16_t>(WS_YM), F.w<bf16_t>(WS_WBR) + (size_t)1024 * 512, TP, 1024, 512};
                    EpiMerge<1> E{F.w<float>(WS_MERGED), F.w<bf16_t>(WS_MB), F.w<bf16_t>(WS_HB), HC_GATE + 1024}; REFRESH(); pg8::gemm_phase(glds, g, S, E, F.tid); }
                  { pg8::Gemm g{F.w<bf16_t>(WS_YH), F.w<bf16_t>(WS_WBR) + (size_t)2 * 1024 * 512, TP, 1024, 512};
                    EpiMerge<2> E{F.w<float>(WS_MERGED), F.w<bf16_t>(WS_MB), F.w<bf16_t>(WS_HB), HC_GATE + 2048}; REFRESH(); pg8::gemm_phase(glds, g, S, E, F.tid); } }
                REFRESH();
                for (int u = F.bid; u < 192; u += F.G) { const int br = u >> 6, nt = u & 63;
                    const bf16_t* ya = (br == 0 ? F.w<bf16_t>(WS_YA) : (br == 1 ? F.w<bf16_t>(WS_YM) : F.w<bf16_t>(WS_YH))) + (size_t)TP * 512;
                    skinny_unit<false, 1>(F, ya, 512, F.w<bf16_t>(WS_WBR) + (size_t)br * 1024 * 512, 512, 0, 512, nt * 16, F.w<float>(WS_MERGED) + (size_t)TP * DM, 1.f, F.w<bf16_t>(WS_HB) + (size_t)TP * NH + HC_GATE + br * 1024); }
                xcd_barrier(xbar);
                { pg8::Gemm g{F.w<bf16_t>(WS_MB), F.w<bf16_t>(WS_WOUT), TP, 1024, 1024}; pg8::StaticOrder S; S.init(TP, 1024, F.G, F.bid);
                  EpiResid E{F.w<float>(WS_X), F.w<bf16_t>(WS_XB), 1.0f}; REFRESH(); pg8::gemm_phase(glds, g, S, E, F.tid); }
                REFRESH();
                for (int u = F.bid; u < 256; u += F.G)
                    skinny_unit<true, 0>(F, F.w<float>(WS_MERGED) + (size_t)TP * DM, 1024, F.w<bf16_t>(WS_WOUT), 1024, (u >> 6) * 256, 256, (u & 63) * 16, F.w<float>(WS_X) + (size_t)TP * DM, 1.f, nullptr);
                xcd_barrier(xbar);
                REFRESH(); phase_ln(F, F.in(I_LN2G) + l * 1024, F.in(I_LN2B) + l * 1024, nullptr);
                xcd_barrier(xbar);
            }
            { pg8::Gemm g{F.w<bf16_t>(WS_XB), F.w<bf16_t>(f ? WS_WGU2 : WS_WGU1), MP, 5632, 1024}; pg8::StaticOrder S; S.init(MP, 5632, F.G, F.bid);
              EpiSwiglu E{F.w<bf16_t>(WS_HB)}; REFRESH();
              { const int nb = (MP / 256) * (5632 / 256) % F.G; if (nb && F.bid >= nb) { if (f == 0) convert_tasks(F, CT_SPLIT, CT_E2, F.bid - nb, F.G - nb); else convert_tasks(F, CT_E5, CT_E6, F.bid - nb, F.G - nb); } }
              REFRESH(); pg8::gemm_phase(glds, g, S, E, F.tid); }
            xcd_barrier(xbar);
            { pg8::Gemm g{F.w<bf16_t>(WS_HB), F.w<bf16_t>(f ? WS_WD2 : WS_WD1), TP, 1024, 2816}; pg8::StaticOrder S; S.init(TP, 1024, F.G, F.bid);
              EpiResid E{F.w<float>(WS_X), F.w<bf16_t>(WS_XB), 0.5f}; REFRESH(); pg8::gemm_phase(glds, g, S, E, F.tid); }
            REFRESH();
            for (int u = F.bid; u < 256; u += F.G)
                skinny_unit<false, 0>(F, F.w<bf16_t>(WS_HB) + (size_t)TP * DFF, DFF, F.w<bf16_t>(f ? WS_WD2 : WS_WD1), DFF, (u >> 6) * 704, 704, (u & 63) * 16, F.w<float>(WS_X) + (size_t)TP * DM, 0.5f, nullptr);
            xcd_barrier(xbar);
            REFRESH(); phase_ln(F, F.in(f ? I_LN3G : I_LN1G) + l * 1024, F.in(f ? I_LN3B : I_LN1B) + l * 1024, (f == 1 && l == 3) ? prm.out : nullptr);
            if (f == 1 && l < 3) { F.l = l + 1; REFRESH(); phase_convert(F); F.l = l; }
            xcd_barrier(xbar);
        }
    }
}

extern "C" void kernel_launch(void* const* d_in, const int* in_sizes, int n_in, void* d_out, int out_size, void* d_ws, size_t ws_size, hipStream_t stream) {
    static int grid = 0;
    if (grid == 0) {
        if (n_in != 34 || (size_t)out_size != O_END || ws_size < WS_END) { fprintf(stderr, "kernel_launch: unexpected shapes n_in %d out %d ws %zu (need %zu)\n", n_in, out_size, ws_size, (size_t)WS_END); grid = -1; return; }
        int dev = 0, cus = 0, per_cu = 0;
        hipGetDevice(&dev); hipDeviceGetAttribute(&cus, hipDeviceAttributeMultiprocessorCount, dev);
        if (hipFuncSetAttribute((const void*)fwd_megakernel, hipFuncAttributeMaxDynamicSharedMemorySize, LDS_BYTES) != hipSuccess) { fprintf(stderr, "kernel_launch: hipFuncSetAttribute failed\n"); grid = -1; return; }
        if (hipOccupancyMaxActiveBlocksPerMultiprocessor(&per_cu, (const void*)fwd_megakernel, NTHR, LDS_BYTES) != hipSuccess || per_cu < 1) { fprintf(stderr, "kernel_launch: occupancy query failed (%d)\n", per_cu); per_cu = 1; (void)hipGetLastError(); }
        if (per_cu > 1) per_cu = 1;
        grid = cus * per_cu;
        if ((long)grid * NTHR < MP) { fprintf(stderr, "kernel_launch: grid too small\n"); grid = -1; return; }
    }
    if (grid < 0) return;
    Params p{};
    for (int i = 0; i < 34; ++i) p.in[i] = (const float*)d_in[i];
    p.out = (float*)d_out; p.ws = (unsigned char*)d_ws;
    if (hipMemsetAsync((char*)d_ws + WS_BAR, 0, (size_t)XCD_BAR_WORDS * 4, stream) != hipSuccess) { fprintf(stderr, "memset failed\n"); return; }
    void* args[] = {&p};
    hipError_t e = hipLaunchCooperativeKernel((const void*)fwd_megakernel, dim3(grid), dim3(NTHR), args, LDS_BYTES, stream);
    if (e != hipSuccess) fprintf(stderr, "cooperative launch failed: %s (grid %d)\n", hipGetErrorString(e), grid);
}
```

```cpp
#include <hip/hip_runtime.h>
#include <hip/hip_cooperative_groups.h>
#include <cstdio>
namespace cg = cooperative_groups;

namespace pg8 {
#define PG8_LAS __attribute__((address_space(3)))
typedef unsigned short bf16_t;
typedef short bf16x8 __attribute__((ext_vector_type(8)));
typedef float f32x4 __attribute__((ext_vector_type(4)));
typedef unsigned u32x4 __attribute__((ext_vector_type(4)));
typedef unsigned u32x2 __attribute__((ext_vector_type(2)));
constexpr int BM = 256, BK = 64, HALF = 128, HTB = HALF * BK * 2, STAGE_BYTES = 8 * HTB, NXCD = 8, WGM = 4;

__host__ __device__ __forceinline__ int lds_byte(int r, int c) { const int st = (r >> 4) * 2 + (c >> 5), rr = r & 15, cc = c & 31, ob = rr * 64 + cc * 2; return st * 1024 + (ob ^ (((ob >> 9) & 1) << 5)); }
__host__ __device__ __forceinline__ void stage_rc(int b, int& R, int& C) { const int st = b / 1024, sb = b % 1024, swz = sb ^ (((sb >> 9) & 1) << 5); R = (st >> 1) * 16 + swz / 64; C = (st & 1) * 32 + (swz % 64) / 2; }
__host__ __device__ __forceinline__ int perm32(int rho) { const int n = rho >> 4, i = rho & 15; return 8 * (i >> 2) + 4 * n + (i & 3); }

struct Unit { int pm, pn; };
struct Gemm { const bf16_t* A; const bf16_t* Bt; int M, N, K; };

struct StaticOrder {
    int nM, nN, nwg, G, c;
    __device__ void init(int M, int N, int G_, int c_) { nM = M / BM; nN = N / BM; nwg = nM * nN; G = G_; c = c_; }
    __device__ bool next(int i, Unit& u) const {
        const long L = (long)i * G + c; if (L >= nwg) return false;
        int wgid = (int)L; { const int q = nwg / NXCD, r = nwg % NXCD, xcd = wgid % NXCD, off = wgid / NXCD; wgid = (xcd < r ? xcd * (q + 1) : r * (q + 1) + (xcd - r) * q) + off; }
        const int nig = WGM * nN, gid = wgid / nig, fm = gid * WGM, gsz = (nM - fm) < WGM ? (nM - fm) : WGM;
        u.pm = fm + ((wgid % nig) % gsz); u.pn = (wgid % nig) / gsz; return true;
    }
};

__device__ __forceinline__ unsigned cvt_pk_bf16(float lo, float hi) { unsigned r; asm volatile("v_cvt_pk_bf16_f32 %0, %1, %2" : "=v"(r) : "v"(lo), "v"(hi)); return r; }

template <class Epi>
__device__ __forceinline__ void gemm_phase(PG8_LAS unsigned char* lds, const Gemm g, const StaticOrder& S, const Epi& E, const int tid) {
    const int wid = __builtin_amdgcn_readfirstlane(tid >> 6), lane = tid & 63, wr = wid >> 2, wc = wid & 3, fr = lane & 15, fq = lane >> 4;
    const int K = g.K, nt = K / BK;
    unsigned voffA[2], voffB[2];
#pragma unroll
    for (int i = 0; i < 2; ++i) { int R, C; stage_rc(tid * 16 + i * 8192, R, C); const int Rb = Epi::PERM ? ((R & ~31) + perm32(R & 31)) : R;
        voffA[i] = (unsigned)(R * K + C) * 2u; voffB[i] = (unsigned)(Rb * K + C) * 2u; }
    const size_t kstep = (size_t)(BK * 2);
    const size_t hstep = (size_t)HALF * K * 2;
    const size_t tstep = 2 * hstep;
    const unsigned ldsw = (unsigned)wid * 1024u;
    const int aoff = lds_byte(wr * 64 + fr, fq * 8), boff = lds_byte(wc * 32 + fr, fq * 8);
#define PG8_SA(b, h) (((b) * 2 + (h)) * HTB)
#define PG8_SB(b, h) ((4 + (b) * 2 + (h)) * HTB)
#define PG8_STAGE(bufoff, gbase, voff) do { _Pragma("unroll") for (int _i = 0; _i < 2; ++_i) \
        __builtin_amdgcn_global_load_lds((const unsigned*)((const char*)(gbase) + (voff)[_i]), (PG8_LAS unsigned*)(lds + (bufoff) + ldsw + _i * 8192), 16, 0, 0); } while (0)
#define PG8_LDA(dst, b, h) do { _Pragma("unroll") for (int m = 0; m < 4; ++m) _Pragma("unroll") for (int k = 0; k < 2; ++k) dst[m][k] = *(const PG8_LAS bf16x8*)(lds + PG8_SA(b, h) + aoff + m * 2048 + k * 1024); } while (0)
#define PG8_LDB(dst, b, h) do { _Pragma("unroll") for (int n = 0; n < 2; ++n) _Pragma("unroll") for (int k = 0; k < 2; ++k) dst[n][k] = *(const PG8_LAS bf16x8*)(lds + PG8_SB(b, h) + boff + n * 2048 + k * 1024); } while (0)
#define PG8_MMA(ai, bj, At, Bt) do { __builtin_amdgcn_s_setprio(1); _Pragma("unroll") for (int m = 0; m < 4; ++m) _Pragma("unroll") for (int n = 0; n < 2; ++n) _Pragma("unroll") for (int k = 0; k < 2; ++k) \
        acc[ai][bj][m][n] = __builtin_amdgcn_mfma_f32_16x16x32_bf16(Bt[n][k], At[m][k], acc[ai][bj][m][n], 0, 0, 0); __builtin_amdgcn_s_setprio(0); } while (0)
#define PG8_WAIT_V(n) asm volatile("s_waitcnt vmcnt(" #n ")" ::: "memory")
#define PG8_WAIT_L(n) asm volatile("s_waitcnt lgkmcnt(" #n ")" ::: "memory")
#define PG8_BAR __builtin_amdgcn_s_barrier()
#define PG8_SCHED __builtin_amdgcn_sched_barrier(0)
    Unit cur, nxt; int ui = 0;
    if (!S.next(0, cur)) return;
    f32x4 acc[2][2][4][2];
#pragma unroll
    for (int a = 0; a < 2; ++a)
#pragma unroll
        for (int b = 0; b < 2; ++b)
#pragma unroll
            for (int m = 0; m < 4; ++m)
#pragma unroll
                for (int n = 0; n < 2; ++n) acc[a][b][m][n] = (f32x4){0.f, 0.f, 0.f, 0.f};
    bf16x8 At[4][2], B0[2][2], B1[2][2];
    const char* cA = (const char*)g.A + (size_t)cur.pm * tstep; const char* cB = (const char*)g.Bt + (size_t)cur.pn * tstep;
    PG8_STAGE(PG8_SB(0, 0), cB, voffB); PG8_STAGE(PG8_SA(0, 0), cA, voffA); PG8_STAGE(PG8_SB(0, 1), cB + hstep, voffB); PG8_STAGE(PG8_SA(0, 1), cA + hstep, voffA);
    if (wr == 1) PG8_BAR;
    PG8_WAIT_V(4); PG8_BAR;
    PG8_STAGE(PG8_SB(1, 0), cB + kstep, voffB); PG8_STAGE(PG8_SA(1, 0), cA + kstep, voffA); PG8_STAGE(PG8_SB(1, 1), cB + hstep + kstep, voffB);
    PG8_WAIT_V(6); PG8_BAR;
    for (;;) {
        const bool has_next = S.next(ui + 1, nxt);
        const char* nA = has_next ? (const char*)g.A + (size_t)nxt.pm * tstep : cA; const char* nB = has_next ? (const char*)g.Bt + (size_t)nxt.pn * tstep : cB;
        for (int t = 0; t < nt; t += 2) {
            const bool last = (t == nt - 2);
            const char* a1 = cA + (size_t)(t + 1) * kstep;
            const char* a2 = last ? nA : cA + (size_t)(t + 2) * kstep; const char* b2 = last ? nB : cB + (size_t)(t + 2) * kstep;
            const char* a3 = a2 + kstep; const char* b3 = b2 + kstep;
            PG8_LDB(B0, 0, 0); PG8_SCHED; PG8_LDA(At, 0, 0); PG8_STAGE(PG8_SA(1, 1), a1 + hstep, voffA);
            PG8_WAIT_L(8); PG8_BAR; PG8_WAIT_L(0); PG8_MMA(0, 0, At, B0); PG8_BAR; PG8_SCHED;
            PG8_LDB(B1, 0, 1); PG8_STAGE(PG8_SB(0, 0), b2, voffB);
            PG8_BAR; PG8_WAIT_L(0); PG8_MMA(0, 1, At, B1); PG8_BAR;
            PG8_LDA(At, 0, 1); PG8_STAGE(PG8_SA(0, 0), a2, voffA);
            PG8_BAR; PG8_WAIT_L(0); PG8_MMA(1, 0, At, B0); PG8_BAR; PG8_SCHED;
            PG8_STAGE(PG8_SB(0, 1), b2 + hstep, voffB);
            PG8_WAIT_V(6); PG8_BAR; PG8_MMA(1, 1, At, B1); PG8_BAR;
            PG8_LDB(B0, 1, 0); PG8_SCHED; PG8_LDA(At, 1, 0); PG8_STAGE(PG8_SA(0, 1), a2 + hstep, voffA);
            PG8_WAIT_L(8); PG8_BAR; PG8_WAIT_L(0); PG8_MMA(0, 0, At, B0); PG8_BAR; PG8_SCHED;
            PG8_LDB(B1, 1, 1); PG8_STAGE(PG8_SB(1, 0), b3, voffB);
            PG8_BAR; PG8_WAIT_L(0); PG8_MMA(0, 1, At, B1); PG8_BAR;
            PG8_LDA(At, 1, 1); PG8_STAGE(PG8_SA(1, 0), a3, voffA);
            PG8_BAR; PG8_WAIT_L(0); PG8_MMA(1, 0, At, B0); PG8_BAR; PG8_SCHED;
            PG8_STAGE(PG8_SB(1, 1), b3 + hstep, voffB);
            PG8_WAIT_V(6); PG8_BAR; PG8_MMA(1, 1, At, B1); PG8_BAR;
        }
        E(acc, cur, wr, wc, fr, fq);
        if (!has_next) break;
#pragma unroll
        for (int a = 0; a < 2; ++a)
#pragma unroll
            for (int b = 0; b < 2; ++b)
#pragma unroll
                for (int m = 0; m < 4; ++m)
#pragma unroll
                    for (int n = 0; n < 2; ++n) acc[a][b][m][n] = (f32x4){0.f, 0.f, 0.f, 0.f};
        cur = nxt; cA = nA; cB = nB; ++ui;
    }
    PG8_WAIT_V(0);
    if (wr == 0) PG8_BAR;
    PG8_BAR;
#undef PG8_SA
#undef PG8_SB
#undef PG8_STAGE
#undef PG8_LDA
#undef PG8_LDB
#undef PG8_MMA
#undef PG8_WAIT_V
#undef PG8_WAIT_L
#undef PG8_BAR
#undef PG8_SCHED
}
}

using pg8::bf16_t; using pg8::bf16x8; using pg8::f32x4; using pg8::u32x4; using pg8::u32x2; using pg8::cvt_pk_bf16;

constexpr int DM = 1024, DFF = 2816, NIN = 7176, NH = 7424;
constexpr int TP = 16384, MS = 128, MR = TP + MS, MP = 16640, SEQ = 4096, NB = 4;
constexpr int NTHR = 512;
constexpr float ALPHA = 1.6817928305074290861f;
constexpr int LDS_GEMM = 131072;
constexpr int LDS_BYTES = 131072 + 16;
constexpr int HC_Q = 0, HC_K = 512, HC_V = 640, HC_Z = 768, HC_XBC = 1280, HC_HQ = 2048, HC_HF = 2560, HC_HI = 3072, HC_HG = 3584, HC_GATE = 4096, HC_DT = 7168;

constexpr size_t al256(size_t x) { return (x + 255) & ~(size_t)255; }
constexpr size_t WS_WGU1 = 0;
constexpr size_t WS_WD1 = WS_WGU1 + (size_t)5632 * 1024 * 2;
constexpr size_t WS_WIN = WS_WD1 + (size_t)1024 * 2816 * 2;
constexpr size_t WS_WBR = WS_WIN + (size_t)NH * 1024 * 2;
constexpr size_t WS_WOUT = WS_WBR + (size_t)3 * 1024 * 512 * 2;
constexpr size_t WS_WGU2 = WS_WOUT + (size_t)1024 * 1024 * 2;
constexpr size_t WS_WD2 = WS_WGU2 + (size_t)5632 * 1024 * 2;
constexpr size_t WS_BIAS = WS_WD2 + (size_t)1024 * 2816 * 2;
constexpr size_t WS_X = al256(WS_BIAS + (size_t)NH * 4);
constexpr size_t WS_XB = WS_X + (size_t)MP * 1024 * 4;
constexpr size_t WS_HB = WS_XB + (size_t)MP * 1024 * 2;
constexpr size_t WS_ACT = WS_HB + (size_t)MP * NH * 2;
constexpr size_t WS_ACUM = WS_ACT + (size_t)TP * 768 * 2;
constexpr size_t WS_MERGED = WS_ACUM + (size_t)TP * 8 * 4;
constexpr size_t WS_YSSD = WS_MERGED;
constexpr size_t WS_OHG = WS_MERGED + (size_t)TP * 512 * 4;
constexpr size_t WS_CS = WS_MERGED + (size_t)MP * 1024 * 4;
constexpr size_t WS_DECS = WS_CS + (size_t)4 * 64 * 8 * 4096 * 4;
constexpr size_t WS_KC = WS_DECS + (size_t)4 * 64 * 8 * 4;
constexpr size_t WS_DECH = WS_KC + (size_t)4 * 4 * 64 * 16384 * 4;
constexpr size_t WS_QE = WS_DECH + (size_t)4 * 4 * 64 * 128 * 4;
constexpr size_t WS_YA = WS_QE + (size_t)TP * 512 * 2;
constexpr size_t WS_YM = WS_YA + (size_t)MP * 512 * 2;
constexpr size_t WS_YH = WS_YM + (size_t)MP * 512 * 2;
constexpr size_t WS_MB = WS_YH + (size_t)MP * 512 * 2;
constexpr size_t WS_BAR = WS_MB + (size_t)MP * 1024 * 2;
constexpr size_t WS_END = WS_BAR + (size_t)3456 * 4;

constexpr size_t O_YP = 0, O_YS = 16777216, O_PK = 16908288, O_PV = 17170432, O_PC = 17432576, O_PSSM = 17469440, O_PHG = 17993728,
                 O_SK = 19042304, O_SV = 27430912, O_SC = 35819520, O_SSSM = 36999168, O_SHG = 53776384, O_END = 87330816;

struct Params { const float* in[34]; float* out; unsigned char* ws; };
enum { I_XP = 0, I_XS, I_CK, I_CV, I_SCONV, I_SSSM, I_SHG, I_LN1G, I_LN1B, I_F1G, I_F1U, I_F1D, I_WIN, I_BIN, I_SINK, I_CONVW, I_CONVB, I_DTB, I_ALOG, I_DSKIP,
       I_SNW, I_LBL, I_HNW, I_WBA, I_WBS, I_WBH, I_WOUT, I_LN2G, I_LN2B, I_F2G, I_F2U, I_F2D, I_LN3G, I_LN3B };

__device__ __forceinline__ float bf2f(bf16_t v) { return __uint_as_float(((unsigned)v) << 16); }
__device__ __forceinline__ bf16_t f2bf(float f) { unsigned u = __float_as_uint(f); u += 0x7FFFu + ((u >> 16) & 1u); return (bf16_t)(u >> 16); }
__device__ __forceinline__ unsigned pk_bf16_c(float lo, float hi) { return (unsigned)f2bf(lo) | ((unsigned)f2bf(hi) << 16); }
__device__ __forceinline__ float sigmoidf_(float x) { return __builtin_amdgcn_rcpf(1.0f + __expf(-x)); }
__device__ __forceinline__ float siluf_(float x) { return x * __builtin_amdgcn_rcpf(1.0f + __expf(-x)); }
__device__ __forceinline__ float siluf_fast(float x) { return x * __builtin_amdgcn_rcpf(1.0f + __expf(-x)); }
__device__ __forceinline__ float softplusf_(float x) { const float e = __expf(x); return x > 20.f ? x : (x < -8.f ? e * (1.0f - 0.5f * e) : __logf(1.0f + e)); }
__device__ __forceinline__ void unpack8(const u32x4 w, float* f) {
    f[0] = __uint_as_float(w.x << 16); f[1] = __uint_as_float(w.x & 0xFFFF0000u); f[2] = __uint_as_float(w.y << 16); f[3] = __uint_as_float(w.y & 0xFFFF0000u);
    f[4] = __uint_as_float(w.z << 16); f[5] = __uint_as_float(w.z & 0xFFFF0000u); f[6] = __uint_as_float(w.w << 16); f[7] = __uint_as_float(w.w & 0xFFFF0000u); }
__device__ __forceinline__ float quad16_sum(float v) { v += __shfl_xor(v, 1); v += __shfl_xor(v, 2); v += __shfl_xor(v, 4); v += __shfl_xor(v, 8); return v; }
__device__ __forceinline__ float quad16_max(float v) { v = fmaxf(v, __shfl_xor(v, 1)); v = fmaxf(v, __shfl_xor(v, 2)); v = fmaxf(v, __shfl_xor(v, 4)); v = fmaxf(v, __shfl_xor(v, 8)); return v; }
__device__ __forceinline__ float wave_sum(float v) { v += __shfl_xor(v, 1); v += __shfl_xor(v, 2); v += __shfl_xor(v, 4); v += __shfl_xor(v, 8); v += __shfl_xor(v, 16); v += __shfl_xor(v, 32); return v; }
__device__ __forceinline__ float wave_max(float v) { v = fmaxf(v, __shfl_xor(v, 1)); v = fmaxf(v, __shfl_xor(v, 2)); v = fmaxf(v, __shfl_xor(v, 4)); v = fmaxf(v, __shfl_xor(v, 8)); v = fmaxf(v, __shfl_xor(v, 16)); v = fmaxf(v, __shfl_xor(v, 32)); return v; }
__device__ __forceinline__ float wave_incl_scan(float v, int lane) {
#pragma unroll
    for (int d = 1; d < 64; d <<= 1) { float o = __shfl_up(v, d); if (lane >= d) v += o; }
    return v; }
__device__ __forceinline__ f32x4 mma16(const bf16_t* A, int lda, const bf16_t* Bt, int ldb, int K, f32x4 acc, int lane) {
    const int r = lane & 15, q = lane >> 4;
    const bf16_t* ap = A + r * lda + q * 8; const bf16_t* bp = Bt + r * ldb + q * 8;
    for (int k0 = 0; k0 < K; k0 += 32) { const bf16x8 a = *(const bf16x8*)(ap + k0); const bf16x8 b = *(const bf16x8*)(bp + k0); acc = __builtin_amdgcn_mfma_f32_16x16x32_bf16(a, b, acc, 0, 0, 0); }
    return acc; }
__device__ __forceinline__ float lb_of(const float* lbl, int l, int ch) {
    const float x0 = lbl[ch], x1 = lbl[512 + ch], x2 = lbl[1024 + ch], x3 = lbl[1536 + ch];
    const float m = fmaxf(fmaxf(x0, x1), fmaxf(x2, x3));
    const float e0 = __expf(x0 - m), e1 = __expf(x1 - m), e2 = __expf(x2 - m), e3 = __expf(x3 - m);
    const float s = e0 + e1 + e2 + e3;
    float acc = 0.f; if (l >= 1) acc += e1; if (l >= 2) acc += e2; if (l >= 3) acc += e3;
    return acc / s; }

struct EpiSwiglu {
    static constexpr bool PERM = true;
    bf16_t* H;
    __device__ __forceinline__ void operator()(const f32x4 (&acc)[2][2][4][2], const pg8::Unit& u, int wr, int wc, int fr, int fq) const {
        const int row0 = u.pm * 256 + wr * 64 + fr, col0 = u.pn * 128 + wc * 32 + 8 * fq;
#pragma unroll
        for (int ai = 0; ai < 2; ++ai)
#pragma unroll
            for (int m = 0; m < 4; ++m) {
                bf16_t* rowp = H + (size_t)(row0 + ai * 128 + m * 16) * DFF + col0;
                float h[8];
#pragma unroll
                for (int n = 0; n < 2; ++n)
#pragma unroll
                    for (int j = 0; j < 4; ++j) h[n * 4 + j] = siluf_fast(acc[ai][0][m][n][j]) * acc[ai][1][m][n][j];
                u32x4 w; w.x = cvt_pk_bf16(h[0], h[1]); w.y = cvt_pk_bf16(h[2], h[3]); w.z = cvt_pk_bf16(h[4], h[5]); w.w = cvt_pk_bf16(h[6], h[7]);
                *(u32x4*)rowp = w; __builtin_amdgcn_sched_barrier(0); }
    }
};
struct EpiResid {
    static constexpr bool PERM = true;
    float* X; const bf16_t* XB; float scale;
    __device__ __forceinline__ void operator()(const f32x4 (&acc)[2][2][4][2], const pg8::Unit& u, int wr, int wc, int fr, int fq) const {
        const int row0 = u.pm * 256 + wr * 64 + fr, col0 = u.pn * 256 + wc * 32 + 8 * fq;
#pragma unroll
        for (int ai = 0; ai < 2; ++ai)
#pragma unroll
            for (int m = 0; m < 4; ++m) { const size_t ro = (size_t)(row0 + ai * 128 + m * 16) * DM + col0;
#pragma unroll
                for (int bj = 0; bj < 2; ++bj) { float b[8]; unpack8(*(const u32x4*)(XB + ro + bj * 128), b);
                    const f32x4 x0 = (f32x4){b[0], b[1], b[2], b[3]}, x1 = (f32x4){b[4], b[5], b[6], b[7]};
                    *(f32x4*)(X + ro + bj * 128) = x0 * ALPHA + acc[ai][bj][m][0] * scale;
                    *(f32x4*)(X + ro + bj * 128 + 4) = x1 * ALPHA + acc[ai][bj][m][1] * scale; } }
    }
};
struct EpiBiasBf16 {
    static constexpr bool PERM = true;
    bf16_t* O; const float* bias;
    __device__ __forceinline__ void operator()(const f32x4 (&acc)[2][2][4][2], const pg8::Unit& u, int wr, int wc, int fr, int fq) const {
        const int row0 = u.pm * 256 + wr * 64 + fr, col0 = u.pn * 256 + wc * 32 + 8 * fq;
        f32x4 bv[2][2];
#pragma unroll
        for (int bj = 0; bj < 2; ++bj)
#pragma unroll
            for (int n = 0; n < 2; ++n) bv[bj][n] = *(const f32x4*)(bias + col0 + bj * 128 + 4 * n);
#pragma unroll
        for (int ai = 0; ai < 2; ++ai)
#pragma unroll
            for (int m = 0; m < 4; ++m) { bf16_t* rowp = O + (size_t)(row0 + ai * 128 + m * 16) * NH + col0;
#pragma unroll
                for (int bj = 0; bj < 2; ++bj) { const f32x4 v0 = acc[ai][bj][m][0] + bv[bj][0], v1 = acc[ai][bj][m][1] + bv[bj][1];
                    u32x4 w; w.x = cvt_pk_bf16(v0[0], v0[1]); w.y = cvt_pk_bf16(v0[2], v0[3]); w.z = cvt_pk_bf16(v1[0], v1[1]); w.w = cvt_pk_bf16(v1[2], v1[3]);
                    *(u32x4*)(rowp + bj * 128) = w; } }
    }
};
template <int MODE> struct EpiMerge {
    static constexpr bool PERM = true;
    float* MG; bf16_t* MB; const bf16_t* HBp; int gcol;
    __device__ __forceinline__ void operator()(const f32x4 (&acc)[2][2][4][2], const pg8::Unit& u, int wr, int wc, int fr, int fq) const {
        const int row0 = u.pm * 256 + wr * 64 + fr, col0 = u.pn * 256 + wc * 32 + 8 * fq;
#pragma unroll
        for (int ai = 0; ai < 2; ++ai)
#pragma unroll
            for (int m = 0; m < 4; ++m) { const size_t row = (size_t)(row0 + ai * 128 + m * 16);
#pragma unroll
                for (int bj = 0; bj < 2; ++bj) { const int c = col0 + bj * 128;
                    float gv[8]; unpack8(*(const u32x4*)(HBp + row * NH + gcol + c), gv);
                    float v[8];
#pragma unroll
                    for (int j = 0; j < 4; ++j) { v[j] = sigmoidf_(gv[j]) * acc[ai][bj][m][0][j]; v[4 + j] = sigmoidf_(gv[4 + j]) * acc[ai][bj][m][1][j]; }
                    u32x4* mp = (u32x4*)(MB + row * DM + c);
                    if (MODE >= 1) { float ov[8]; unpack8(*mp, ov);
#pragma unroll
                        for (int j = 0; j < 8; ++j) v[j] += ov[j]; }
                    u32x4 w; w.x = cvt_pk_bf16(v[0], v[1]); w.y = cvt_pk_bf16(v[2], v[3]); w.z = cvt_pk_bf16(v[4], v[5]); w.w = cvt_pk_bf16(v[6], v[7]); *mp = w; } }
    }
};

#define XB_TMO      128
#define XB_XCNT(j)  (256  + 64 * (j))
#define XB_XSUB(j)  (1280 + 64 * (j))
#define XB_XGEN(j)  (2304 + 64 * (j))
#define XB_TOP      3328
#define XB_TOPGEN   3392
#define XCD_BAR_WORDS 3456
#define XB_SPIN_CAP (1u << 18)
#define LAS __attribute__((address_space(3)))
__device__ __forceinline__ unsigned xb_ld(unsigned* p)              { return __hip_atomic_load(p, __ATOMIC_RELAXED, __HIP_MEMORY_SCOPE_AGENT); }
__device__ __forceinline__ unsigned xb_add(unsigned* p, unsigned v) { return __hip_atomic_fetch_add(p, v, __ATOMIC_RELAXED, __HIP_MEMORY_SCOPE_AGENT); }
__device__ __forceinline__ unsigned xb_xcc_id() { return (unsigned)__builtin_amdgcn_s_getreg((3 << 11) | 20) & 0xFu; }
#define XB_SPIN(cond, bar) do { unsigned _sp = 0; while (cond) { __builtin_amdgcn_s_sleep(1); \
    if ((++_sp & 255u) == 0u) { if (xb_ld(&(bar)[XB_TMO])) break; if (_sp > XB_SPIN_CAP) { atomicAdd(&(bar)[XB_TMO], 1u); break; } } } } while (0)
struct XcdBarrier { unsigned* bar; unsigned x; volatile LAS unsigned* st; };
__device__ __forceinline__ XcdBarrier xcd_barrier_post(unsigned* bar, volatile LAS unsigned* st) {
    XcdBarrier b; b.bar = bar; b.x = xb_xcc_id(); b.st = st;
    if (threadIdx.x == 0) (void)xb_add(&bar[XB_XCNT(b.x)], 1u);
    return b;
}
__device__ __forceinline__ void xcd_barrier_complete(unsigned* bar, unsigned x, unsigned& nloc, unsigned& nx) {
    const unsigned G = gridDim.x * gridDim.y * gridDim.z;
    unsigned sum, cnt, mine, sp = 0u;
    for (;;) {
        sum = 0u; cnt = 0u; mine = 0u;
#pragma unroll
        for (unsigned j = 0; j < 16; ++j) { const unsigned c = xb_ld(&bar[XB_XCNT(j)]); sum += c; cnt += (c > 0u) ? 1u : 0u; mine = (j == x) ? c : mine; }
        if (sum == G) break;
        __builtin_amdgcn_s_sleep(1);
        if ((++sp & 255u) == 0u) { if (xb_ld(&bar[XB_TMO])) break; if (sp > XB_SPIN_CAP) { atomicAdd(&bar[XB_TMO], 1u); break; } }
    }
    nloc = mine > 0u ? mine : 1u; nx = cnt > 0u ? cnt : 1u;
}
__device__ __forceinline__ void xcd_barrier(const XcdBarrier& b) {
    asm volatile("s_waitcnt vmcnt(0)" ::: "memory");
    __syncthreads();
    if (threadIdx.x == 0) {
        unsigned* bar = b.bar;
        __builtin_amdgcn_s_waitcnt(0);
        unsigned nloc = b.st[0], nx = b.st[1];
        if (nloc == 0u) { xcd_barrier_complete(bar, b.x, nloc, nx); b.st[0] = nloc; b.st[1] = nx; }
        const unsigned old = xb_add(&bar[XB_XSUB(b.x)], 1u);
        const unsigned gen = old / nloc;
        if (old + 1u == (gen + 1u) * nloc) {
            __builtin_amdgcn_fence(__ATOMIC_RELEASE, "agent");
            asm volatile("s_waitcnt vmcnt(0)" ::: "memory");
            const unsigned og = xb_add(&bar[XB_TOP], 1u);
            const unsigned tg = og / nx;
            if (og + 1u == (tg + 1u) * nx) xb_add(&bar[XB_TOPGEN], 1u);
            else XB_SPIN(xb_ld(&bar[XB_TOPGEN]) == tg, bar);
            __builtin_amdgcn_fence(__ATOMIC_ACQUIRE, "agent");
            xb_add(&bar[XB_XGEN(b.x)], 1u);
            asm volatile("s_waitcnt vmcnt(0)" ::: "memory");
        } else {
            XB_SPIN(xb_ld(&bar[XB_XGEN(b.x)]) == gen, bar);
            __builtin_amdgcn_fence(__ATOMIC_ACQUIRE, "agent");
            asm volatile("s_waitcnt vmcnt(0)" ::: "memory");
        }
    }
    __syncthreads();
}

struct Frame {
    const Params* p; unsigned char* ws; unsigned char* sm; int tid, lane, wave, G, bid, l;
    __device__ __forceinline__ const float* in(int i) const { return p->in[i]; }
    template <class T> __device__ __forceinline__ T* w(size_t off) const { return (T*)(ws + off); }
};

__device__ __forceinline__ int win_map(int n) { return n < 2048 ? n : (n < 4096 ? n + 8 : (n < 7168 ? n + 8 : (n < 7176 ? n - 7168 + 2048 : -1))); }
__device__ __forceinline__ void tconv_task(const Frame& F, const float* src, const float* src2, int Nsrc, int K, bf16_t* dst, int n0, int k0, int mode, const float* g, const float* b, float* cs, float* bw) {
    float* tile = (float*)F.sm;
    float* colsum = tile + 4 * 64 * 65;
    __syncthreads();
    if (F.tid < 128) colsum[F.tid] = 0.f;
    const int n4 = (F.tid & 15) * 4, n = n0 + n4;
    const float* sp = src; int col = n;
    if (mode == 1) { const int t = n >> 8, r = n & 255; sp = (r < 128) ? src : src2; col = t * 128 + (r & 127); }
    else if (mode == 2) col = win_map(n);
    f32x4 v[4][2];
#pragma unroll
    for (int j = 0; j < 4; ++j)
#pragma unroll
        for (int i = 0; i < 2; ++i) { const int kk = (F.tid >> 4) + i * 32;
            v[j][i] = (col >= 0) ? __builtin_nontemporal_load((const f32x4*)(sp + (size_t)(k0 + j * 64 + kk) * Nsrc + col)) : (f32x4){0.f, 0.f, 0.f, 0.f}; }
    __syncthreads();
    f32x4 csa = (f32x4){0.f, 0.f, 0.f, 0.f}, bwa = csa;
#pragma unroll
    for (int j = 0; j < 4; ++j)
#pragma unroll
        for (int i = 0; i < 2; ++i) { const int kk = (F.tid >> 4) + i * 32, k = k0 + j * 64 + kk; f32x4 w = v[j][i];
            if (cs) { const float gk = g ? g[k] : 1.f, bk = b ? b[k] : 0.f; bwa += w * bk; w *= gk;
#pragma unroll
                for (int c = 0; c < 4; ++c) { w[c] = bf2f(f2bf(w[c])); } csa += w; }
#pragma unroll
            for (int c = 0; c < 4; ++c) tile[(j * 64 + kk) * 65 + n4 + c] = w[c]; }
    if (cs) {
#pragma unroll
        for (int c = 0; c < 4; ++c) { float a = csa[c], bb = bwa[c]; a += __shfl_xor(a, 16); a += __shfl_xor(a, 32); bb += __shfl_xor(bb, 16); bb += __shfl_xor(bb, 32);
            if (F.lane < 16) { atomicAdd(&colsum[(n4 + c) * 2], a); atomicAdd(&colsum[(n4 + c) * 2 + 1], bb); } } }
    __syncthreads();
    for (int e = F.tid; e < 64 * 128; e += NTHR) { const int nn = e >> 7, kp = (e & 127) * 2;
        *(unsigned*)(dst + (size_t)(n0 + nn) * K + k0 + kp) = cvt_pk_bf16(tile[kp * 65 + nn], tile[(kp + 1) * 65 + nn]); }
    if (cs && F.tid < 64) { atomicAdd(cs + n0 + F.tid, colsum[F.tid * 2]); atomicAdd(bw + n0 + F.tid, colsum[F.tid * 2 + 1]); }
}
constexpr int CT_E0 = 352, CT_E1 = 528, CT_E2 = 992, CT_E3 = 1088, CT_E4 = 1152, CT_E5 = 1504, CT_E6 = 1680, CT_SPLIT = 674;
__device__ __forceinline__ void convert_tasks(const Frame& F, int lo, int hi, int start, int stride) {
    const int l = F.l;
    const int nt3 = (1024 / 64) * 2;
    const int e0 = CT_E0, e1 = CT_E1, e2 = CT_E2, e3 = CT_E3, e4 = CT_E4, e5 = CT_E5;
    for (int t = lo + start; t < hi; t += stride) {
        if (t < e0) tconv_task(F, F.in(I_F1G) + (size_t)l * 1024 * DFF, F.in(I_F1U) + (size_t)l * 1024 * DFF, DFF, 1024, F.w<bf16_t>(WS_WGU1), (t >> 2) * 64, (t & 3) * 256, 1, nullptr, nullptr, nullptr, nullptr);
        else if (t < e1) { const int u = t - e0; tconv_task(F, F.in(I_F1D) + (size_t)l * DFF * 1024, nullptr, 1024, 2816, F.w<bf16_t>(WS_WD1), (u / 11) * 64, (u % 11) * 256, 0, nullptr, nullptr, nullptr, nullptr); }
        else if (t < e2) { const int u = t - e1; tconv_task(F, F.in(I_WIN) + (size_t)l * 1024 * NIN, nullptr, NIN, 1024, F.w<bf16_t>(WS_WIN), (u >> 2) * 64, (u & 3) * 256, 2, nullptr, nullptr, nullptr, nullptr); }
        else if (t < e3) { int u = t - e2; const int br = u / nt3; u -= br * nt3;
            const float* sp = (br == 0 ? F.in(I_WBA) : (br == 1 ? F.in(I_WBS) : F.in(I_WBH))) + (size_t)l * 512 * 1024;
            tconv_task(F, sp, nullptr, 1024, 512, F.w<bf16_t>(WS_WBR) + (size_t)br * 1024 * 512, (u >> 1) * 64, (u & 1) * 256, 0, nullptr, nullptr, nullptr, nullptr); }
        else if (t < e4) { const int u = t - e3; tconv_task(F, F.in(I_WOUT) + (size_t)l * 1024 * 1024, nullptr, 1024, 1024, F.w<bf16_t>(WS_WOUT), (u >> 2) * 64, (u & 3) * 256, 0, nullptr, nullptr, nullptr, nullptr); }
        else if (t < e5) { const int u = t - e4; tconv_task(F, F.in(I_F2G) + (size_t)l * 1024 * DFF, F.in(I_F2U) + (size_t)l * 1024 * DFF, DFF, 1024, F.w<bf16_t>(WS_WGU2), (u >> 2) * 64, (u & 3) * 256, 1, nullptr, nullptr, nullptr, nullptr); }
        else { const int u = t - e5; tconv_task(F, F.in(I_F2D) + (size_t)l * DFF * 1024, nullptr, 1024, 2816, F.w<bf16_t>(WS_WD2), (u / 11) * 64, (u % 11) * 256, 0, nullptr, nullptr, nullptr, nullptr); }
    }
    __syncthreads();
}
__device__ __forceinline__ void phase_convert(const Frame& F) {
    const int l = F.l;
    convert_tasks(F, 0, CT_SPLIT, F.bid, F.G);
    float* bp = F.w<float>(WS_BIAS);
    { const int n = F.bid * NTHR + F.tid; if (n < NH) { const int c = win_map(n); bp[n] = c >= 0 ? F.in(I_BIN)[(size_t)l * NIN + c] : 0.f; } }
    if (l == 0) {
        float* X = F.w<float>(WS_X); bf16_t* XB = F.w<bf16_t>(WS_XB);
        const size_t n4 = (size_t)MP * 256;
        for (size_t i = (size_t)F.bid * NTHR + F.tid; i < n4; i += (size_t)F.G * NTHR) {
            const size_t row = i >> 8; f32x4 v = (f32x4){0.f, 0.f, 0.f, 0.f};
            if (row < TP) v = __builtin_nontemporal_load((const f32x4*)F.in(I_XP) + i); else if (row < MR) v = ((const f32x4*)F.in(I_XS))[i - (size_t)TP * 256];
            if (row >= TP) ((f32x4*)X)[i] = v * ALPHA; u32x2 w; w.x = cvt_pk_bf16(v[0], v[1]); w.y = cvt_pk_bf16(v[2], v[3]); ((u32x2*)XB)[i] = w; }
    }
}

__device__ __forceinline__ void phase_ln(const Frame& F, const float* g, const float* b, float* final_out) {
    float* X = F.w<float>(WS_X); bf16_t* XB = F.w<bf16_t>(WS_XB);
    for (int row0 = (F.bid * 8 + F.wave) * 2; row0 < MP; row0 += F.G * 16) {
        f32x4 v[2][4]; float s[2] = {0.f, 0.f};
#pragma unroll
        for (int r = 0; r < 2; ++r)
#pragma unroll
            for (int j = 0; j < 4; ++j) v[r][j] = __builtin_nontemporal_load((const f32x4*)(X + (size_t)(row0 + r) * DM + j * 256 + F.lane * 4));
#pragma unroll
        for (int r = 0; r < 2; ++r)
#pragma unroll
            for (int j = 0; j < 4; ++j) s[r] += v[r][j][0] + v[r][j][1] + v[r][j][2] + v[r][j][3];
        const float mu0 = wave_sum(s[0]) * (1.0f / DM), mu1 = wave_sum(s[1]) * (1.0f / DM); float q[2] = {0.f, 0.f};
#pragma unroll
        for (int r = 0; r < 2; ++r)
#pragma unroll
            for (int j = 0; j < 4; ++j) { v[r][j] -= (r ? mu1 : mu0); q[r] += v[r][j][0] * v[r][j][0] + v[r][j][1] * v[r][j][1] + v[r][j][2] * v[r][j][2] + v[r][j][3] * v[r][j][3]; }
        const float rs0 = rsqrtf(wave_sum(q[0]) * (1.0f / DM) + 1e-5f), rs1 = rsqrtf(wave_sum(q[1]) * (1.0f / DM) + 1e-5f);
#pragma unroll
        for (int j = 0; j < 4; ++j) { const int c = j * 256 + F.lane * 4; const f32x4 gv = *(const f32x4*)(g + c), bv = *(const f32x4*)(b + c);
#pragma unroll
            for (int r = 0; r < 2; ++r) { const size_t row = (size_t)(row0 + r); const f32x4 o = v[r][j] * (r ? rs1 : rs0) * gv + bv;
                if (row >= TP) *(f32x4*)(X + row * DM + c) = o * ALPHA;
                u32x2 w; w.x = cvt_pk_bf16(o[0], o[1]); w.y = cvt_pk_bf16(o[2], o[3]); *(u32x2*)(XB + row * DM + c) = w;
                if (final_out && row < MR) __builtin_nontemporal_store(o, (f32x4*)(final_out + row * DM + c)); } }
    }
}

__device__ __forceinline__ void item_attn(const Frame& F, int item) {
    const int l = F.l, qb = item & 63, kvh = (item >> 6) & 1, b = item >> 7, q0 = qb * 64, kp0 = q0 - 128;
    const bf16_t* HB = F.w<bf16_t>(WS_HB); bf16_t* YA = F.w<bf16_t>(WS_YA);
    constexpr int KP = 72, VP = 216, PP = 168;
    bf16_t* Ks = (bf16_t*)F.sm;
    bf16_t* Vt = Ks + 192 * KP;
    bf16_t* Pw = Vt + 64 * VP + F.wave * 16 * PP;
    const size_t rowb = (size_t)b * SEQ;
    __syncthreads();
    for (int e = F.tid; e < 208 * 8; e += NTHR) { const int j = e >> 3, d8 = (e & 7) * 8, pos = kp0 + j;
        u32x4 kw = (u32x4){0u, 0u, 0u, 0u}, vw = kw;
        if (j < 192 && pos >= 0) { const bf16_t* hr = HB + (rowb + pos) * NH; kw = *(const u32x4*)(hr + HC_K + kvh * 64 + d8); vw = *(const u32x4*)(hr + HC_V + kvh * 64 + d8); }
        if (j < 192) *(u32x4*)(Ks + j * KP + d8) = kw;
        const unsigned vv[4] = {vw.x, vw.y, vw.z, vw.w};
#pragma unroll
        for (int i = 0; i < 4; ++i) { Vt[(d8 + 2 * i) * VP + j] = (bf16_t)(vv[i] & 0xFFFFu); Vt[(d8 + 2 * i + 1) * VP + j] = (bf16_t)(vv[i] >> 16); }
        if (qb >= 62 && j >= 128 && j < 192) {
            float kf[8], vf[8]; unpack8(kw, kf); unpack8(vw, vf);
            float* pk = F.p->out + O_PK + ((((size_t)l * NB + b) * 128 + (pos - (SEQ - 128))) * 2 + kvh) * 64 + d8;
            float* pv = F.p->out + O_PV + ((((size_t)l * NB + b) * 128 + (pos - (SEQ - 128))) * 2 + kvh) * 64 + d8;
#pragma unroll
            for (int i = 0; i < 8; ++i) { pk[i] = kf[i]; pv[i] = vf[i]; } }
    }
    __syncthreads();
    const int hh = F.wave >> 1, qh = F.wave & 1, h = kvh * 4 + hh, lane = F.lane, c = lane & 15, quad = lane >> 4;
    const float slope = exp2f(-(float)(h + 1)), sink = F.in(I_SINK)[l * 8 + h];
    for (int mt = 0; mt < 2; ++mt) {
        const int base = qh * 32 + mt * 16;
        const bf16_t* qp = HB + (rowb + q0 + base + c) * NH + HC_Q + h * 64 + quad * 8;
        const bf16x8 a0 = *(const bf16x8*)qp, a1 = *(const bf16x8*)(qp + 32);
        f32x4 s[9];
#pragma unroll
        for (int nt = 0; nt < 9; ++nt) { const bf16_t* kp = Ks + (base + nt * 16 + c) * KP + quad * 8;
            f32x4 acc = (f32x4){0.f, 0.f, 0.f, 0.f};
            acc = __builtin_amdgcn_mfma_f32_16x16x32_bf16(a0, *(const bf16x8*)kp, acc, 0, 0, 0);
            acc = __builtin_amdgcn_mfma_f32_16x16x32_bf16(a1, *(const bf16x8*)(kp + 32), acc, 0, 0, 0);
            s[nt] = acc; }
        float mx[4] = {-1e30f, -1e30f, -1e30f, -1e30f};
#pragma unroll
        for (int nt = 0; nt < 9; ++nt) { const int kpos = kp0 + base + nt * 16 + c;
#pragma unroll
            for (int j = 0; j < 4; ++j) { const int r = quad * 4 + j, dist = 128 + r - nt * 16 - c;
                const bool ok = (dist >= 0) && (dist <= 128) && (kpos >= 0);
                const float v = ok ? s[nt][j] * 0.125f - slope * (float)dist : -1e30f; s[nt][j] = v; mx[j] = fmaxf(mx[j], v); } }
        float den[4];
#pragma unroll
        for (int j = 0; j < 4; ++j) { mx[j] = fmaxf(quad16_max(mx[j]), sink); den[j] = 0.f; }
#pragma unroll
        for (int nt = 0; nt < 9; ++nt)
#pragma unroll
            for (int j = 0; j < 4; ++j) { const float pz = __expf(s[nt][j] - mx[j]); den[j] += pz; Pw[(quad * 4 + j) * PP + nt * 16 + c] = f2bf(pz); }
#pragma unroll
        for (int j = 0; j < 4; ++j) { den[j] = __builtin_amdgcn_rcpf(quad16_sum(den[j]) + __expf(sink - mx[j])); Pw[(quad * 4 + j) * PP + 144 + c] = 0; }
        f32x4 o[4];
#pragma unroll
        for (int nt = 0; nt < 4; ++nt) o[nt] = mma16(Pw, PP, Vt + (nt * 16) * VP + base, VP, 160, (f32x4){0.f, 0.f, 0.f, 0.f}, lane);
#pragma unroll
        for (int nt = 0; nt < 4; ++nt)
#pragma unroll
            for (int j = 0; j < 4; ++j) YA[(rowb + q0 + base + quad * 4 + j) * 512 + h * 64 + nt * 16 + c] = f2bf(o[nt][j] * den[j]);
    }
}

__device__ __forceinline__ void item_attn_dec(const Frame& F, int b) {
    const int l = F.l; const size_t sr = (size_t)TP + b;
    const bf16_t* HB = F.w<bf16_t>(WS_HB); bf16_t* YA = F.w<bf16_t>(WS_YA);
    constexpr int KVP = 129;
    float* KV = (float*)F.sm;
    float* Qs = KV + 129 * KVP;
    float* Ps = Qs + 512;
    const float* ck = F.in(I_CK) + ((size_t)l * MS + b) * 128 * 128; const float* cv = F.in(I_CV) + ((size_t)l * MS + b) * 128 * 128;
    float* ok = F.p->out + O_SK + ((size_t)l * MS + b) * 128 * 128; float* ov = F.p->out + O_SV + ((size_t)l * MS + b) * 128 * 128;
    __syncthreads();
    for (int e0 = F.tid; e0 < 128 * 128; e0 += NTHR * 8) { float v[8];
#pragma unroll
        for (int i = 0; i < 8; ++i) v[i] = __builtin_nontemporal_load(ck + e0 + i * NTHR);
#pragma unroll
        for (int i = 0; i < 8; ++i) { const int e = e0 + i * NTHR, j = e >> 7, cc = e & 127; KV[j * KVP + cc] = v[i]; if (j >= 1) __builtin_nontemporal_store(v[i], ok + e - 128); } }
    if (F.tid < 128) { const float v = bf2f(HB[sr * NH + HC_K + F.tid]); KV[128 * KVP + F.tid] = v; ok[127 * 128 + F.tid] = v; }
    Qs[F.tid] = bf2f(HB[sr * NH + HC_Q + F.tid]);
    { float* mg = F.w<float>(WS_MERGED) + sr * DM; mg[F.tid] = 0.f; mg[512 + F.tid] = 0.f; }
    __syncthreads();
    for (int idx = F.tid; idx < 8 * 129; idx += NTHR) { const int h = idx / 129, j = idx - h * 129, kvh = h >> 2;
        float s = 0.f;
#pragma unroll 8
        for (int d = 0; d < 64; ++d) s += Qs[h * 64 + d] * KV[j * KVP + kvh * 64 + d];
        Ps[h * 132 + j] = s * 0.125f - exp2f(-(float)(h + 1)) * (float)(128 - j); }
    __syncthreads();
    { const int h = F.wave; const float sink = F.in(I_SINK)[l * 8 + h];
      const float s0 = Ps[h * 132 + F.lane], s1 = Ps[h * 132 + 64 + F.lane], s2 = (F.lane == 0) ? Ps[h * 132 + 128] : -1e30f;
      const float m = fmaxf(wave_max(fmaxf(fmaxf(s0, s1), s2)), sink);
      const float p0 = __expf(s0 - m), p1 = __expf(s1 - m), p2 = (F.lane == 0) ? __expf(s2 - m) : 0.f;
      const float den = wave_sum(p0 + p1 + p2) + __expf(sink - m), inv = 1.0f / den;
      Ps[h * 132 + F.lane] = p0 * inv; Ps[h * 132 + 64 + F.lane] = p1 * inv; if (F.lane == 0) Ps[h * 132 + 128] = p2 * inv; }
    __syncthreads();
    for (int e0 = F.tid; e0 < 128 * 128; e0 += NTHR * 8) { float v[8];
#pragma unroll
        for (int i = 0; i < 8; ++i) v[i] = __builtin_nontemporal_load(cv + e0 + i * NTHR);
#pragma unroll
        for (int i = 0; i < 8; ++i) { const int e = e0 + i * NTHR, j = e >> 7, cc = e & 127; KV[j * KVP + cc] = v[i]; if (j >= 1) __builtin_nontemporal_store(v[i], ov + e - 128); } }
    if (F.tid < 128) { const float v = bf2f(HB[sr * NH + HC_V + F.tid]); KV[128 * KVP + F.tid] = v; ov[127 * 128 + F.tid] = v; }
    __syncthreads();
    { const int h = F.tid >> 6, d = F.tid & 63, kvh = h >> 2; float o = 0.f;
      for (int j = 0; j < 129; ++j) o += Ps[h * 132 + j] * KV[j * KVP + kvh * 64 + d];
      YA[sr * 512 + F.tid] = f2bf(o); }
}

__device__ __forceinline__ void item_ssd_a(const Frame& F, int item) {
    const int l = F.l, g = item & 1, c = (item >> 1) & 63, b = item >> 7, t0 = c * 64;
    const size_t r0 = (size_t)b * SEQ + t0;
    const bf16_t* HB = F.w<bf16_t>(WS_HB); bf16_t* ACT = F.w<bf16_t>(WS_ACT);
    constexpr int P = 72;
    bf16_t* Bn = (bf16_t*)F.sm;
    bf16_t* Cn = Bn + 64 * P;
    bf16_t* xT = Cn + 64 * P;
    bf16_t* Wp = xT + 4 * 64 * P + F.wave * 32 * P;
    float* a_s = (float*)(xT + 4 * 64 * P + 8 * 32 * P);
    float* dt_s = a_s + 256;
    __syncthreads();
    if (F.wave < 4) { const int h = g * 4 + F.wave, t = F.lane;
        const float dt = softplusf_(bf2f(HB[(r0 + t) * NH + HC_DT + h]) + F.in(I_DTB)[l * 8 + h]);
        const float A = -__expf(F.in(I_ALOG)[l * 8 + h]);
        const float a = wave_incl_scan(dt * A, t);
        a_s[t * 4 + F.wave] = a; dt_s[t * 4 + F.wave] = dt;
        F.w<float>(WS_ACUM)[(r0 + t) * 8 + h] = a;
        if (t == 63) F.w<float>(WS_DECS)[((size_t)b * 64 + c) * 8 + h] = __expf(a); }
    const float* cw = F.in(I_CONVW) + (size_t)l * 4 * 768; const float* cb = F.in(I_CONVB) + (size_t)l * 768;
    for (int e = F.tid; e < 48 * 64; e += NTHR) { const int t = e & 63, cg8 = e >> 6;
        const int ch = cg8 < 32 ? g * 256 + cg8 * 8 : (cg8 < 40 ? 512 + g * 64 + (cg8 - 32) * 8 : 640 + g * 64 + (cg8 - 40) * 8);
        float acc[8];
#pragma unroll
        for (int i = 0; i < 8; ++i) acc[i] = cb[ch + i];
#pragma unroll
        for (int w = 0; w < 4; ++w) { const int tt = t0 + t - 3 + w;
            if (tt >= 0) { float xv[8]; unpack8(*(const u32x4*)(HB + ((size_t)b * SEQ + tt) * NH + HC_XBC + ch), xv);
                const f32x4 w0 = *(const f32x4*)(cw + w * 768 + ch), w1 = *(const f32x4*)(cw + w * 768 + ch + 4);
#pragma unroll
                for (int i = 0; i < 4; ++i) { acc[i] += xv[i] * w0[i]; acc[4 + i] += xv[4 + i] * w1[i]; } } }
        bf16_t ob[8];
#pragma unroll
        for (int i = 0; i < 8; ++i) ob[i] = f2bf(siluf_(acc[i]));
        u32x4 w; w.x = ob[0] | ((unsigned)ob[1] << 16); w.y = ob[2] | ((unsigned)ob[3] << 16); w.z = ob[4] | ((unsigned)ob[5] << 16); w.w = ob[6] | ((unsigned)ob[7] << 16);
        *(u32x4*)(ACT + (r0 + t) * 768 + ch) = w;
        if (cg8 < 32) { const int hh = cg8 >> 3, p0 = (cg8 & 7) * 8;
#pragma unroll
            for (int i = 0; i < 8; ++i) xT[(hh * 64 + p0 + i) * P + t] = ob[i]; }
        else if (cg8 < 40) *(u32x4*)(Bn + t * P + (cg8 - 32) * 8) = w;
        else *(u32x4*)(Cn + t * P + (cg8 - 40) * 8) = w;
        if (c == 63 && t >= 61) {
            float xv[8]; unpack8(*(const u32x4*)(HB + (r0 + t) * NH + HC_XBC + ch), xv);
            float* pc = F.p->out + O_PC + (((size_t)l * NB + b) * 3 + (t - 61)) * 768 + ch;
#pragma unroll
            for (int i = 0; i < 8; ++i) pc[i] = xv[i]; }
    }
    __syncthreads();
    const int hh = F.wave >> 1, th = F.wave & 1, h = g * 4 + hh, lane = F.lane, cc = lane & 15, quad = lane >> 4;
#pragma unroll
    for (int mt = 0; mt < 2; ++mt)
#pragma unroll
        for (int nt = 0; nt < 4; ++nt) {
            f32x4 gt = (f32x4){0.f, 0.f, 0.f, 0.f};
            if (nt <= th * 2 + mt) gt = mma16(Cn + (th * 32 + mt * 16) * P, P, Bn + (nt * 16) * P, P, 64, gt, lane);
            const int s = nt * 16 + cc; const float as = a_s[s * 4 + hh], dts = dt_s[s * 4 + hh];
#pragma unroll
            for (int j = 0; j < 4; ++j) { const int t = th * 32 + mt * 16 + quad * 4 + j;
                const float w = (s <= t) ? gt[j] * __expf(a_s[t * 4 + hh] - as) * dts : 0.f;
                Wp[(mt * 16 + quad * 4 + j) * P + s] = f2bf(w); } }
    bf16_t* Y = F.w<bf16_t>(WS_YSSD);
#pragma unroll
    for (int mt = 0; mt < 2; ++mt)
#pragma unroll
        for (int nt = 0; nt < 4; ++nt) {
            const f32x4 y = mma16(xT + (hh * 64 + nt * 16) * P, P, Wp + (mt * 16) * P, P, 64, (f32x4){0.f, 0.f, 0.f, 0.f}, lane);
            u32x2 w; w.x = pk_bf16_c(y[0], y[1]); w.y = pk_bf16_c(y[2], y[3]); *(u32x2*)(Y + (r0 + th * 32 + mt * 16 + cc) * 512 + h * 64 + nt * 16 + quad * 4) = w; }
    { const float al = a_s[63 * 4 + hh];
      for (int e = lane; e < 32 * 64; e += 64) { const int s = e & 63, nl = e >> 6;
          Wp[nl * P + s] = f2bf(bf2f(Bn[s * P + th * 32 + nl]) * __expf(al - a_s[s * 4 + hh]) * dt_s[s * 4 + hh]); } }
    bf16_t* CS = F.w<bf16_t>(WS_CS) + (((size_t)b * 64 + c) * 8 + h) * 4096;
#pragma unroll
    for (int mt = 0; mt < 4; ++mt)
#pragma unroll
        for (int nt = 0; nt < 2; ++nt) {
            const f32x4 v = mma16(Wp + (nt * 16) * P, P, xT + (hh * 64 + mt * 16) * P, P, 64, (f32x4){0.f, 0.f, 0.f, 0.f}, lane);
            u32x2 w; w.x = pk_bf16_c(v[0], v[1]); w.y = pk_bf16_c(v[2], v[3]); *(u32x2*)(CS + (mt * 16 + cc) * 64 + th * 32 + nt * 16 + quad * 4) = w; }
}

__device__ __forceinline__ void item_ssd_dec(const Frame& F, int b) {
    const int l = F.l; const size_t sr = (size_t)TP + b;
    const bf16_t* HB = F.w<bf16_t>(WS_HB);
    float* act = (float*)F.sm;
    float* ys = act + 768;
    float* red = ys + 512;
    __syncthreads();
    const float* cw = F.in(I_CONVW) + (size_t)l * 4 * 768; const float* cb = F.in(I_CONVB) + (size_t)l * 768;
    const float* sc = F.in(I_SCONV) + ((size_t)l * MS + b) * 3 * 768; float* oc = F.p->out + O_SC + ((size_t)l * MS + b) * 3 * 768;
    for (int ch = F.tid; ch < 768; ch += NTHR) { const float o0 = sc[ch], o1 = sc[768 + ch], o2 = sc[1536 + ch], nw = bf2f(HB[sr * NH + HC_XBC + ch]);
        act[ch] = siluf_(o0 * cw[ch] + o1 * cw[768 + ch] + o2 * cw[1536 + ch] + nw * cw[2304 + ch] + cb[ch]);
        oc[ch] = o1; oc[768 + ch] = o2; oc[1536 + ch] = nw; }
    __syncthreads();
    { const int h = F.wave, g = h >> 2, n = F.lane;
      const float dt = softplusf_(bf2f(HB[sr * NH + HC_DT + h]) + F.in(I_DTB)[l * 8 + h]);
      const float dA = __expf(dt * -__expf(F.in(I_ALOG)[l * 8 + h]));
      const float Bv = act[512 + g * 64 + n] * dt, Cv = act[640 + g * 64 + n], Dh = F.in(I_DSKIP)[l * 8 + h];
      const float* s0 = F.in(I_SSSM) + (((size_t)l * MS + b) * 8 + h) * 4096; float* s1 = F.p->out + O_SSSM + (((size_t)l * MS + b) * 8 + h) * 4096;
#pragma unroll 16
      for (int p = 0; p < 64; ++p) { const float x = act[h * 64 + p]; const float hT = dA * __builtin_nontemporal_load(s0 + p * 64 + n) + x * Bv; __builtin_nontemporal_store(hT, s1 + p * 64 + n);
          const float y = wave_sum(Cv * hT);
          if (n == 0) ys[h * 64 + p] = (y + Dh * x) * siluf_(bf2f(HB[sr * NH + HC_Z + h * 64 + p])); } }
    __syncthreads();
    { const float y = ys[F.tid]; const float q = wave_sum(y * y); if (F.lane == 0) red[F.wave] = q; __syncthreads();
      float tot = 0.f;
#pragma unroll
      for (int i = 0; i < 8; ++i) tot += red[i];
      F.w<bf16_t>(WS_YM)[sr * 512 + F.tid] = f2bf(y * rsqrtf(tot * (1.0f / 512.f) + 1e-6f) * F.in(I_SNW)[l * 512 + F.tid]); }
}

__device__ __forceinline__ void item_ssd_c(const Frame& F, int item) {
    const int l = F.l, c = item & 63, b = item >> 6; const size_t r0 = (size_t)b * SEQ + c * 64;
    const bf16_t* HB = F.w<bf16_t>(WS_HB); const bf16_t* ACT = F.w<bf16_t>(WS_ACT);
    constexpr int P = 72;
    bf16_t* Cn = (bf16_t*)F.sm;
    bf16_t* Hn = Cn + 2 * 64 * P + F.wave * 64 * P;
    float* ssq = (float*)(Cn + 2 * 64 * P + 8 * 64 * P);
    const int h = F.wave, g = h >> 2, lane = F.lane, cc = lane & 15, quad = lane >> 4;
    __syncthreads();
    for (int e = F.tid; e < 2 * 64 * 8; e += NTHR) { const int n8 = (e & 7) * 8, t = (e >> 3) & 63, gg = e >> 9;
        *(u32x4*)(Cn + (gg * 64 + t) * P + n8) = *(const u32x4*)(ACT + (r0 + t) * 768 + 640 + gg * 64 + n8); }
    { const bf16_t* hs = F.w<bf16_t>(WS_CS) + (((size_t)b * 64 + c) * 8 + h) * 4096;
      for (int e = lane; e < 64 * 8; e += 64) { const int p = e >> 3, n8 = (e & 7) * 8; *(u32x4*)(Hn + p * P + n8) = *(const u32x4*)(hs + p * 64 + n8); } }
    __syncthreads();
    const float Dh = F.in(I_DSKIP)[l * 8 + h];
    const bf16_t* Y = F.w<bf16_t>(WS_YSSD); const float* AC = F.w<float>(WS_ACUM);
    f32x4 y[4][4];
#pragma unroll
    for (int mt = 0; mt < 4; ++mt) { const size_t row = r0 + mt * 16 + cc;
        const float ea = __expf(AC[row * 8 + h]); float q = 0.f;
#pragma unroll
        for (int nt = 0; nt < 4; ++nt) { const f32x4 v = mma16(Hn + (nt * 16) * P, P, Cn + (g * 64 + mt * 16) * P, P, 64, (f32x4){0.f, 0.f, 0.f, 0.f}, lane);
            const int col = h * 64 + nt * 16 + quad * 4;
            const u32x2 yw = *(const u32x2*)(Y + row * 512 + col); const float yi[4] = {__uint_as_float(yw.x << 16), __uint_as_float(yw.x & 0xFFFF0000u), __uint_as_float(yw.y << 16), __uint_as_float(yw.y & 0xFFFF0000u)};
            const u32x2 xw = *(const u32x2*)(ACT + row * 768 + col), zw = *(const u32x2*)(HB + row * NH + HC_Z + col);
            const float xv[4] = {__uint_as_float(xw.x << 16), __uint_as_float(xw.x & 0xFFFF0000u), __uint_as_float(xw.y << 16), __uint_as_float(xw.y & 0xFFFF0000u)};
            const float zv[4] = {__uint_as_float(zw.x << 16), __uint_as_float(zw.x & 0xFFFF0000u), __uint_as_float(zw.y << 16), __uint_as_float(zw.y & 0xFFFF0000u)};
#pragma unroll
            for (int j = 0; j < 4; ++j) { float yy = (yi[j] + ea * v[j] + Dh * xv[j]) * siluf_(zv[j]); y[mt][nt][j] = yy; q += yy * yy; } }
        q += __shfl_xor(q, 16); q += __shfl_xor(q, 32);
        if (quad == 0) ssq[h * 64 + mt * 16 + cc] = q; }
    __syncthreads();
    bf16_t* YM = F.w<bf16_t>(WS_YM); const float* nw = F.in(I_SNW) + l * 512;
#pragma unroll
    for (int mt = 0; mt < 4; ++mt) { const int t = mt * 16 + cc; float tot = 0.f;
#pragma unroll
        for (int i = 0; i < 8; ++i) tot += ssq[i * 64 + t];
        const float rstd = rsqrtf(tot * (1.0f / 512.f) + 1e-6f);
#pragma unroll
        for (int nt = 0; nt < 4; ++nt) { const int col = h * 64 + nt * 16 + quad * 4; const f32x4 w4 = *(const f32x4*)(nw + col);
            u32x2 w; w.x = cvt_pk_bf16(y[mt][nt][0] * rstd * w4[0], y[mt][nt][1] * rstd * w4[1]); w.y = cvt_pk_bf16(y[mt][nt][2] * rstd * w4[2], y[mt][nt][3] * rstd * w4[3]);
            *(u32x2*)(YM + (r0 + t) * 512 + col) = w; } }
}

__device__ __forceinline__ void item_hg_a(const Frame& F, int item) {
    const int l = F.l, c = item & 63, hd = (item >> 6) & 3, b = item >> 8; const size_t r0 = (size_t)b * SEQ + c * 64;
    const bf16_t* HB = F.w<bf16_t>(WS_HB);
    constexpr int QP = 130, BP = 129, P = 72;
    bf16_t* q_s = (bf16_t*)F.sm;
    bf16_t* k_s = q_s + 64 * QP;
    float* bc = (float*)(k_s + 64 * QP);
    bf16_t* att = (bf16_t*)(bc + 64 * BP);
    bf16_t* iT = att + 64 * P;
    bf16_t* keT = iT + 128 * P;
    const int lane = F.lane, cc = lane & 15, quad = lane >> 4;
    float* lbs = (float*)(keT + 128 * P);
    __syncthreads();
    if (F.tid < 128) lbs[F.tid] = lb_of(F.in(I_LBL), l, hd * 128 + F.tid);
    __syncthreads();
    for (int e = F.tid; e < 64 * 16; e += NTHR) { const int t = e >> 4, k8 = (e & 15) * 8; const bf16_t* hr = HB + (r0 + t) * NH + hd * 128 + k8;
        float qv[8], fv[8]; unpack8(*(const u32x4*)(hr + HC_HQ), qv); unpack8(*(const u32x4*)(hr + HC_HF), fv);
        const u32x4 iw = *(const u32x4*)(hr + HC_HI); const unsigned iv[4] = {iw.x, iw.y, iw.z, iw.w};
#pragma unroll
        for (int i = 0; i < 8; ++i) { const float lbv = lbs[k8 + i];
            const float sg = __builtin_amdgcn_rcpf(1.0f + __expf(-fv[i])), sgn = __builtin_amdgcn_rcpf(1.0f + __expf(fv[i]));
            q_s[t * QP + k8 + i] = f2bf(siluf_(qv[i])); k_s[t * QP + k8 + i] = f2bf((1.0f - lbv) * sgn);
            bc[t * BP + k8 + i] = __logf(lbv + (1.0f - lbv) * sg); }
#pragma unroll
        for (int i = 0; i < 4; ++i) { iT[(k8 + 2 * i) * P + t] = (bf16_t)(iv[i] & 0xFFFFu); iT[(k8 + 2 * i + 1) * P + t] = (bf16_t)(iv[i] >> 16); } }
    __syncthreads();
    for (int k = F.wave; k < 128; k += 8) bc[lane * BP + k] = wave_incl_scan(bc[lane * BP + k], lane);
    __syncthreads();
    constexpr int DP = 136;
    bf16_t* qd = (bf16_t*)(lbs + 128);
    bf16_t* kd = keT;
    for (int e = F.tid; e < 64 * 128; e += NTHR) { const int r = e >> 7, k = e & 127;
        const int ref = r < 32 ? 31 : (r < 48 ? 15 : 47), t = r < 32 ? 32 + r : (r < 48 ? r - 16 : r), sx = r < 32 ? r : (r < 48 ? r - 32 : r - 16);
        const float br = bc[ref * BP + k];
        qd[r * DP + k] = f2bf(bf2f(q_s[t * QP + k]) * __expf(bc[t * BP + k] - br));
        kd[r * DP + k] = f2bf(bf2f(k_s[sx * QP + k]) * __expf(br - bc[sx * BP + k])); }
    { const int idx = F.tid, B = idx / 136, p = idx - B * 136;
      int i = (int)((sqrtf(8.0f * (float)p + 1.0f) - 1.0f) * 0.5f); while ((i + 1) * (i + 2) / 2 <= p) ++i; while (i * (i + 1) / 2 > p) --i;
      const int j = p - i * (i + 1) / 2, t = 16 * B + i, sx = 16 * B + j; float a = 0.f;
#pragma unroll 4
      for (int k = 0; k < 128; ++k) a += bf2f(q_s[t * QP + k]) * bf2f(k_s[sx * QP + k]) * __expf(bc[t * BP + k] - bc[sx * BP + k]);
      att[t * P + sx] = f2bf(a); }
    { const int p = 512 + (F.tid >> 4) - 3 * 136, ks = (F.tid & 15) * 8;
      int i = (int)((sqrtf(8.0f * (float)p + 1.0f) - 1.0f) * 0.5f); while ((i + 1) * (i + 2) / 2 <= p) ++i; while (i * (i + 1) / 2 > p) --i;
      const int j = p - i * (i + 1) / 2, t = 48 + i, sx = 48 + j; float a = 0.f;
#pragma unroll
      for (int k = ks; k < ks + 8; ++k) a += bf2f(q_s[t * QP + k]) * bf2f(k_s[sx * QP + k]) * __expf(bc[t * BP + k] - bc[sx * BP + k]);
      a = quad16_sum(a); if ((F.tid & 15) == 0) att[t * P + sx] = f2bf(a); }
    for (int e = F.tid; e < 64 * 64; e += NTHR) { const int t = e >> 6, sx = e & 63; if (sx > t) att[t * P + sx] = 0; }
    __syncthreads();
    if (F.wave < 6) { const int w = F.wave; const int qr = w < 4 ? (w >> 1) * 16 : (w == 4 ? 32 : 48), kr = w < 4 ? (w & 1) * 16 : (w == 4 ? 32 : 48);
        const int t0 = w < 4 ? 32 + (w >> 1) * 16 : (w == 4 ? 16 : 48), s0 = w < 4 ? (w & 1) * 16 : (w == 4 ? 0 : 32);
        const f32x4 v = mma16(qd + qr * DP, DP, kd + kr * DP, DP, 128, (f32x4){0.f, 0.f, 0.f, 0.f}, lane);
#pragma unroll
        for (int j = 0; j < 4; ++j) att[(t0 + quad * 4 + j) * P + s0 + cc] = f2bf(v[j]); }
    __syncthreads();
    bf16_t* QE = F.w<bf16_t>(WS_QE);
    for (int e = F.tid; e < 64 * 128; e += NTHR) { const int s = e >> 7, k = e & 127; const float bb = bc[s * BP + k];
        keT[k * P + s] = f2bf(bf2f(k_s[s * QP + k]) * __expf(bc[63 * BP + k] - bb));
        QE[(r0 + s) * 512 + hd * 128 + k] = f2bf(bf2f(q_s[s * QP + k]) * __expf(bb)); }
    if (F.tid < 128) F.w<float>(WS_DECH)[(((size_t)b * 4 + hd) * 64 + c) * 128 + F.tid] = __expf(bc[63 * BP + F.tid]);
    __syncthreads();
    bf16_t* OH = F.w<bf16_t>(WS_OHG);
    { const int mt = F.wave >> 1;
#pragma unroll
      for (int n4 = 0; n4 < 4; ++n4) { const int nt = (F.wave & 1) * 4 + n4;
          const f32x4 v = mma16(iT + (nt * 16) * P, P, att + (mt * 16) * P, P, 64, (f32x4){0.f, 0.f, 0.f, 0.f}, lane);
          u32x2 w; w.x = pk_bf16_c(v[0], v[1]); w.y = pk_bf16_c(v[2], v[3]); *(u32x2*)(OH + (r0 + mt * 16 + cc) * 512 + hd * 128 + nt * 16 + quad * 4) = w; } }
    bf16_t* KC = F.w<bf16_t>(WS_KC) + (((size_t)b * 4 + hd) * 64 + c) * 16384;
#pragma unroll
    for (int nt = 0; nt < 8; ++nt) { const f32x4 v = mma16(keT + (F.wave * 16) * P, P, iT + (nt * 16) * P, P, 64, (f32x4){0.f, 0.f, 0.f, 0.f}, lane);
        { u32x2 w; w.x = pk_bf16_c(v[0], v[1]); w.y = pk_bf16_c(v[2], v[3]); *(u32x2*)(KC + (nt * 16 + cc) * 128 + F.wave * 16 + quad * 4) = w; } }
}

__device__ __forceinline__ void item_hg_c(const Frame& F, int item) {
    const int l = F.l, c = item & 63, hd = (item >> 6) & 3, b = item >> 8; const size_t r0 = (size_t)b * SEQ + c * 64;
    const bf16_t* HB = F.w<bf16_t>(WS_HB);
    constexpr int P = 136;
    bf16_t* qe = (bf16_t*)F.sm;
    bf16_t* ST = qe + 64 * P;
    float* ssq = (float*)(ST + 128 * P);
    const int lane = F.lane, cc = lane & 15, quad = lane >> 4;
    __syncthreads();
    const bf16_t* QE = F.w<bf16_t>(WS_QE);
    for (int e = F.tid; e < 64 * 16; e += NTHR) { const int t = e >> 4, k8 = (e & 15) * 8; *(u32x4*)(qe + t * P + k8) = *(const u32x4*)(QE + (r0 + t) * 512 + hd * 128 + k8); }
    const bf16_t* Sp = F.w<bf16_t>(WS_KC) + (((size_t)b * 4 + hd) * 64 + c) * 16384;
    for (int e = F.tid; e < 128 * 16; e += NTHR) { const int v = e >> 4, k8 = (e & 15) * 8; *(u32x4*)(ST + v * P + k8) = *(const u32x4*)(Sp + v * 128 + k8); }
    __syncthreads();
    const int mt = F.wave >> 1, nh = F.wave & 1;
    const bf16_t* OH = F.w<bf16_t>(WS_OHG); const size_t row = r0 + mt * 16 + cc;
    f32x4 o[4]; float q = 0.f;
#pragma unroll
    for (int n4 = 0; n4 < 4; ++n4) { const int nt = nh * 4 + n4;
        o[n4] = mma16(ST + (nt * 16) * P, P, qe + (mt * 16) * P, P, 128, (f32x4){0.f, 0.f, 0.f, 0.f}, lane);
        { const u32x2 ow = *(const u32x2*)(OH + row * 512 + hd * 128 + nt * 16 + quad * 4); o[n4][0] += __uint_as_float(ow.x << 16); o[n4][1] += __uint_as_float(ow.x & 0xFFFF0000u); o[n4][2] += __uint_as_float(ow.y << 16); o[n4][3] += __uint_as_float(ow.y & 0xFFFF0000u); }
        q += o[n4][0] * o[n4][0] + o[n4][1] * o[n4][1] + o[n4][2] * o[n4][2] + o[n4][3] * o[n4][3]; }
    q += __shfl_xor(q, 16); q += __shfl_xor(q, 32);
    if (quad == 0) ssq[nh * 64 + mt * 16 + cc] = q;
    __syncthreads();
    bf16_t* YH = F.w<bf16_t>(WS_YH); const float* nw = F.in(I_HNW) + l * 128;
    { const int t = mt * 16 + cc; const float rstd = rsqrtf((ssq[t] + ssq[64 + t]) * (1.0f / 128.f) + 1e-6f);
#pragma unroll
      for (int n4 = 0; n4 < 4; ++n4) { const int v0 = (nh * 4 + n4) * 16 + quad * 4; const f32x4 w4 = *(const f32x4*)(nw + v0);
          const u32x2 gw = *(const u32x2*)(HB + row * NH + HC_HG + hd * 128 + v0);
          const float g0 = siluf_(__uint_as_float(gw.x << 16)), g1 = siluf_(__uint_as_float(gw.x & 0xFFFF0000u)), g2 = siluf_(__uint_as_float(gw.y << 16)), g3 = siluf_(__uint_as_float(gw.y & 0xFFFF0000u));
          u32x2 w; w.x = cvt_pk_bf16(o[n4][0] * rstd * w4[0] * g0, o[n4][1] * rstd * w4[1] * g1); w.y = cvt_pk_bf16(o[n4][2] * rstd * w4[2] * g2, o[n4][3] * rstd * w4[3] * g3);
          *(u32x2*)(YH + row * 512 + hd * 128 + v0) = w; } }
}

__device__ __forceinline__ void item_hg_dec(const Frame& F, int item) {
    const int l = F.l, hd = item & 3, b = item >> 2; const size_t sr = (size_t)TP + b;
    const bf16_t* HB = F.w<bf16_t>(WS_HB);
    float* fq = (float*)F.sm;
    float* op = fq + 384;
    float* red = op + 512;
    __syncthreads();
    if (F.tid < 128) { const int k = F.tid; const float lbv = lb_of(F.in(I_LBL), l, hd * 128 + k); const float fl = bf2f(HB[sr * NH + HC_HF + hd * 128 + k]);
        fq[k] = lbv + (1.0f - lbv) / (1.0f + __expf(-fl)); fq[128 + k] = (1.0f - lbv) / (1.0f + __expf(fl)); fq[256 + k] = siluf_(bf2f(HB[sr * NH + HC_HQ + hd * 128 + k])); }
    __syncthreads();
    const int kq = F.tid >> 7, v = F.tid & 127; const float iv = bf2f(HB[sr * NH + HC_HI + hd * 128 + v]);
    const float* s0 = F.in(I_SHG) + (((size_t)l * MS + b) * 4 + hd) * 16384; float* s1 = F.p->out + O_SHG + (((size_t)l * MS + b) * 4 + hd) * 16384;
    float o = 0.f;
#pragma unroll 16
    for (int k = kq * 32; k < kq * 32 + 32; ++k) { const float sn = fq[k] * __builtin_nontemporal_load(s0 + k * 128 + v) + fq[128 + k] * iv; __builtin_nontemporal_store(sn, s1 + k * 128 + v); o += fq[256 + k] * sn; }
    op[kq * 128 + v] = o;
    __syncthreads();
    if (F.tid < 128) { const float ov = op[v] + op[128 + v] + op[256 + v] + op[384 + v]; const float q = wave_sum(ov * ov); if (F.lane == 0) red[F.wave] = q; op[v] = ov; }
    __syncthreads();
    if (F.tid < 128) { const float rstd = rsqrtf((red[0] + red[1]) * (1.0f / 128.f) + 1e-6f);
        F.w<bf16_t>(WS_YH)[sr * 512 + hd * 128 + v] = f2bf(op[v] * rstd * F.in(I_HNW)[l * 128 + v] * siluf_(bf2f(HB[sr * NH + HC_HG + hd * 128 + v]))); }
}

__device__ __forceinline__ void phase_scan(const Frame& F) {
    const int l = F.l;
    if (F.tid < 256) { unsigned* CS = F.w<unsigned>(WS_CS); const float* DE = F.w<float>(WS_DECS);
      for (int e = F.bid * 256 + F.tid; e < 4 * 8 * 2048; e += F.G * 256) { const int b = e >> 14, h = (e >> 11) & 7, pn2 = e & 2047; float S0 = 0.f, S1 = 0.f;
          unsigned* base = CS + ((size_t)b * 64 * 8 + h) * 2048 + pn2; const float* db = DE + (size_t)b * 64 * 8 + h;
          for (int c0 = 0; c0 < 64; c0 += 16) { unsigned v[16]; float d[16];
#pragma unroll
              for (int i = 0; i < 16; ++i) { v[i] = base[(size_t)(c0 + i) * 8 * 2048]; d[i] = db[(c0 + i) * 8]; }
#pragma unroll
              for (int i = 0; i < 16; ++i) { base[(size_t)(c0 + i) * 8 * 2048] = cvt_pk_bf16(S0, S1); S0 = d[i] * S0 + __uint_as_float(v[i] << 16); S1 = d[i] * S1 + __uint_as_float(v[i] & 0xFFFF0000u); } }
          *(float2*)(F.p->out + O_PSSM + (((size_t)l * NB + b) * 8 + h) * 4096 + pn2 * 2) = make_float2(S0, S1); } }
    { unsigned* KC = F.w<unsigned>(WS_KC); const float* DE = F.w<float>(WS_DECH); const int gt = F.bid * NTHR + F.tid, gn = F.G * NTHR;
      for (int e = gt; e < 4 * 4 * 8192; e += gn) { const int bh = e >> 13, kv = (e & 8191) * 2, k = kv & 127, vv = kv >> 7; float S0 = 0.f, S1 = 0.f;
          unsigned* base = KC + (size_t)bh * 64 * 8192 + (kv >> 1); const float* db = DE + (size_t)bh * 64 * 128 + k;
          for (int c0 = 0; c0 < 64; c0 += 16) { unsigned v[16]; float2 d[16];
#pragma unroll
              for (int i = 0; i < 16; ++i) { v[i] = base[(size_t)(c0 + i) * 8192]; d[i] = *(const float2*)(db + (c0 + i) * 128); }
#pragma unroll
              for (int i = 0; i < 16; ++i) { base[(size_t)(c0 + i) * 8192] = cvt_pk_bf16(S0, S1); S0 = d[i].x * S0 + __uint_as_float(v[i] << 16); S1 = d[i].y * S1 + __uint_as_float(v[i] & 0xFFFF0000u); } }
          float* po = F.p->out + O_PHG + ((size_t)l * 16 + bh) * 16384; po[k * 128 + vv] = S0; po[(k + 1) * 128 + vv] = S1; } }
}

template <bool A_F32, int MODE>
__device__ __forceinline__ void skinny_unit(const Frame& F, const void* A, int lda, const bf16_t* Bt, int ldb, int kbeg, int klen, int n0, float* out, float scale, const bf16_t* gate) {
    const int m0 = F.wave * 16, r = F.lane & 15, q = F.lane >> 4;
    f32x4 acc = (f32x4){0.f, 0.f, 0.f, 0.f};
    const bf16_t* bp = Bt + (size_t)(n0 + r) * ldb + kbeg + q * 8;
    if (!A_F32) { const bf16_t* ap = (const bf16_t*)A + (size_t)(m0 + r) * lda + kbeg + q * 8;
#pragma unroll 8
        for (int k = 0; k < klen; k += 32) acc = __builtin_amdgcn_mfma_f32_16x16x32_bf16(*(const bf16x8*)(ap + k), *(const bf16x8*)(bp + k), acc, 0, 0, 0); }
    else { const float* ap = (const float*)A + (size_t)(m0 + r) * lda + kbeg + q * 8;
#pragma unroll 4
        for (int k = 0; k < klen; k += 32) { const f32x4 x0 = *(const f32x4*)(ap + k), x1 = *(const f32x4*)(ap + k + 4);
            u32x4 w; w.x = cvt_pk_bf16(x0[0], x0[1]); w.y = cvt_pk_bf16(x0[2], x0[3]); w.z = cvt_pk_bf16(x1[0], x1[1]); w.w = cvt_pk_bf16(x1[2], x1[3]);
            bf16x8 a; __builtin_memcpy(&a, &w, 16);
            acc = __builtin_amdgcn_mfma_f32_16x16x32_bf16(a, *(const bf16x8*)(bp + k), acc, 0, 0, 0); } }
#pragma unroll
    for (int j = 0; j < 4; ++j) { const int row = m0 + q * 4 + j, col = n0 + r;
        float v = acc[j] * scale;
        if (MODE == 1) v = acc[j] * sigmoidf_(bf2f(gate[(size_t)row * NH + col]));
        atomicAdd(out + (size_t)row * DM + col, v); }
}

__global__ void __launch_bounds__(NTHR, 2) fwd_megakernel(Params prm) {
    extern __shared__ __attribute__((aligned(16))) unsigned char lds[];
    cg::grid_group grid = cg::this_grid();
    Frame F; F.p = &prm; F.ws = prm.ws; F.sm = lds; F.tid = threadIdx.x; F.lane = F.tid & 63; F.wave = __builtin_amdgcn_readfirstlane(F.tid >> 6); F.G = gridDim.x; F.bid = blockIdx.x; F.l = 0;
    PG8_LAS unsigned char* glds = (PG8_LAS unsigned char*)lds;
    if (threadIdx.x < 4) ((volatile LAS unsigned*)(glds + LDS_GEMM))[threadIdx.x] = 0u;
    __syncthreads();
    XcdBarrier xbar = xcd_barrier_post((unsigned*)(prm.ws + WS_BAR), (volatile LAS unsigned*)(glds + LDS_GEMM));
#define REFRESH() do { int t_ = threadIdx.x; asm volatile("" : "+v"(t_)); F.tid = t_; F.lane = t_ & 63; F.wave = __builtin_amdgcn_readfirstlane(t_ >> 6); } while (0)
    for (int l = 0; l < 4; ++l) {
        F.l = l;
        if (l == 0) { REFRESH(); phase_convert(F); grid.sync(); }
        for (int f = 0; f < 2; ++f) {
            if (f == 1) {
                { pg8::Gemm g{F.w<bf16_t>(WS_XB), F.w<bf16_t>(WS_WIN), MP, NH, 1024}; pg8::StaticOrder S; S.init(MP, NH, F.G, F.bid);
                  EpiBiasBf16 E{F.w<bf16_t>(WS_HB), F.w<float>(WS_BIAS)}; REFRESH();
                  { const int nb = (MP / 256) * (NH / 256) % F.G; if (nb && F.bid >= nb) convert_tasks(F, CT_E2, CT_E5, F.bid - nb, F.G - nb); }
                  REFRESH(); pg8::gemm_phase(glds, g, S, E, F.tid); }
                xcd_barrier(xbar);
                for (int it = F.bid; it < 2816; it += F.G) { REFRESH();
                    if (it < 512) item_attn(F, it); else if (it < 1024) item_ssd_a(F, it - 512); else if (it < 2048) item_hg_a(F, it - 1024);
                    else if (it < 2176) item_attn_dec(F, it - 2048); else if (it < 2304) item_ssd_dec(F, it - 2176); else item_hg_dec(F, it - 2304); }
                xcd_barrier(xbar);
                REFRESH(); phase_scan(F);
                xcd_barrier(xbar);
                for (int it = F.bid; it < 1280; it += F.G) { REFRESH(); if (it < 256) item_ssd_c(F, it); else item_hg_c(F, it - 256); }
                __syncthreads();
                xcd_barrier(xbar);
                { pg8::StaticOrder S; S.init(TP, 1024, F.G, F.bid);
                  { pg8::Gemm g{F.w<bf16_t>(WS_YA), F.w<bf16_t>(WS_WBR), TP, 1024, 512};
                    EpiMerge<0> E{F.w<float>(WS_MERGED), F.w<bf16_t>(WS_MB), F.w<bf16_t>(WS_HB), HC_GATE}; REFRESH(); pg8::gemm_phase(glds, g, S, E, F.tid); }
                  { pg8::Gemm g{F.w<bf16_t>(WS_YM), F.w<bf16_t>(WS_WBR) + (size_t)1024 * 512, TP, 1024, 512};
                    EpiMerge<1> E{F.w<float>(WS_MERGED), F.w<bf16_t>(WS_MB), F.w<bf16_t>(WS_HB), HC_GATE + 1024}; REFRESH(); pg8::gemm_phase(glds, g, S, E, F.tid); }
                  { pg8::Gemm g{F.w<bf16_t>(WS_YH), F.w<bf16_t>(WS_WBR) + (size_t)2 * 1024 * 512, TP, 1024, 512};
                    EpiMerge<2> E{F.w<float>(WS_MERGED), F.w<bf16_t>(WS_MB), F.w<bf16_t>(WS_HB), HC_GATE + 2048}; REFRESH(); pg8::gemm_phase(glds, g, S, E, F.tid); } }
                REFRESH();
                for (int u = F.bid; u < 192; u += F.G) { const int br = u >> 6, nt = u & 63;
                    const bf16_t* ya = (br == 0 ? F.w<bf16_t>(WS_YA) : (br == 1 ? F.w<bf16_t>(WS_YM) : F.w<bf16_t>(WS_YH))) + (size_t)TP * 512;
                    skinny_unit<false, 1>(F, ya, 512, F.w<bf16_t>(WS_WBR) + (size_t)br * 1024 * 512, 512, 0, 512, nt * 16, F.w<float>(WS_MERGED) + (size_t)TP * DM, 1.f, F.w<bf16_t>(WS_HB) + (size_t)TP * NH + HC_GATE + br * 1024); }
                xcd_barrier(xbar);
                { pg8::Gemm g{F.w<bf16_t>(WS_MB), F.w<bf16_t>(WS_WOUT), TP, 1024, 1024}; pg8::StaticOrder S; S.init(TP, 1024, F.G, F.bid);
                  EpiResid E{F.w<float>(WS_X), F.w<bf16_t>(WS_XB), 1.0f}; REFRESH(); pg8::gemm_phase(glds, g, S, E, F.tid); }
                REFRESH();
                for (int u = F.bid; u < 256; u += F.G)
                    skinny_unit<true, 0>(F, F.w<float>(WS_MERGED) + (size_t)TP * DM, 1024, F.w<bf16_t>(WS_WOUT), 1024, (u >> 6) * 256, 256, (u & 63) * 16, F.w<float>(WS_X) + (size_t)TP * DM, 1.f, nullptr);
                xcd_barrier(xbar);
                REFRESH(); phase_ln(F, F.in(I_LN2G) + l * 1024, F.in(I_LN2B) + l * 1024, nullptr);
                xcd_barrier(xbar);
            }
            { pg8::Gemm g{F.w<bf16_t>(WS_XB), F.w<bf16_t>(f ? WS_WGU2 : WS_WGU1), MP, 5632, 1024}; pg8::StaticOrder S; S.init(MP, 5632, F.G, F.bid);
              EpiSwiglu E{F.w<bf16_t>(WS_HB)}; REFRESH();
              { const int nb = (MP / 256) * (5632 / 256) % F.G; if (nb && F.bid >= nb) { if (f == 0) convert_tasks(F, CT_SPLIT, CT_E2, F.bid - nb, F.G - nb); else convert_tasks(F, CT_E5, CT_E6, F.bid - nb, F.G - nb); } }
              REFRESH(); pg8::gemm_phase(glds, g, S, E, F.tid); }
            xcd_barrier(xbar);
            { pg8::Gemm g{F.w<bf16_t>(WS_HB), F.w<bf16_t>(f ? WS_WD2 : WS_WD1), TP, 1024, 2816}; pg8::StaticOrder S; S.init(TP, 1024, F.G, F.bid);
              EpiResid E{F.w<float>(WS_X), F.w<bf16_t>(WS_XB), 0.5f}; REFRESH(); pg8::gemm_phase(glds, g, S, E, F.tid); }
            REFRESH();
            for (int u = F.bid; u < 256; u += F.G)
                skinny_unit<false, 0>(F, F.w<bf16_t>(WS_HB) + (size_t)TP * DFF, DFF, F.w<bf16_t>(f ? WS_WD2 : WS_WD1), DFF, (u >> 6) * 704, 704, (u & 63) * 16, F.w<float>(WS_X) + (size_t)TP * DM, 0.5f, nullptr);
            xcd_barrier(xbar);
            REFRESH(); phase_ln(F, F.in(f ? I_LN3G : I_LN1G) + l * 1024, F.in(f ? I_LN3B : I_LN1B) + l * 1024, (f == 1 && l == 3) ? prm.out : nullptr);
            if (f == 1 && l < 3) { F.l = l + 1; REFRESH(); phase_convert(F); F.l = l; }
            xcd_barrier(xbar);
        }
    }
}

extern "C" void kernel_launch(void* const* d_in, const int* in_sizes, int n_in, void* d_out, int out_size, void* d_ws, size_t ws_size, hipStream_t stream) {
    static int grid = 0;
    if (grid == 0) {
        if (n_in != 34 || (size_t)out_size != O_END || ws_size < WS_END) { fprintf(stderr, "kernel_launch: unexpected shapes n_in %d out %d ws %zu (need %zu)\n", n_in, out_size, ws_size, (size_t)WS_END); grid = -1; return; }
        int dev = 0, cus = 0, per_cu = 0;
        hipGetDevice(&dev); hipDeviceGetAttribute(&cus, hipDeviceAttributeMultiprocessorCount, dev);
        if (hipFuncSetAttribute((const void*)fwd_megakernel, hipFuncAttributeMaxDynamicSharedMemorySize, LDS_BYTES) != hipSuccess) { fprintf(stderr, "kernel_launch: hipFuncSetAttribute failed\n"); grid = -1; return; }
        if (hipOccupancyMaxActiveBlocksPerMultiprocessor(&per_cu, (const void*)fwd_megakernel, NTHR, LDS_BYTES) != hipSuccess || per_cu < 1) { fprintf(stderr, "kernel_launch: occupancy query failed (%d)\n", per_cu); per_cu = 1; (void)hipGetLastError(); }
        if (per_cu > 1) per_cu = 1;
        grid = cus * per_cu;
        if ((long)grid * NTHR < MP) { fprintf(stderr, "kernel_launch: grid too small\n"); grid = -1; return; }
    }
    if (grid < 0) return;
    Params p{};
    for (int i = 0; i < 34; ++i) p.in[i] = (const float*)d_in[i];
    p.out = (float*)d_out; p.ws = (unsigned char*)d_ws;
    if (hipMemsetAsync((char*)d_ws + WS_BAR, 0, (size_t)XCD_BAR_WORDS * 4, stream) != hipSuccess) { fprintf(stderr, "memset failed\n"); return; }
    void* args[] = {&p};
    hipError_t e = hipLaunchCooperativeKernel((const void*)fwd_megakernel, dim3(grid), dim3(NTHR), args, LDS_BYTES, stream);
    if (e != hipSuccess) fprintf(stderr, "cooperative launch failed: %s (grid %d)\n", hipGetErrorString(e), grid);
}
```
